# Optimizing an MI355X kernel written in HIP

```python
import jax, jax.numpy as jnp
from jax import lax
import numpy as np

D_MODEL = 1024
BATCH = 8
SEQ = 4096
DEPTH = 1

N_META = 16
BLOCK = 128
LEAD_PAD = BLOCK - N_META
SB_HEAD_DIM = 64
SB_WIDTH = D_MODEL // 2
SB_HEADS = SB_WIDTH // SB_HEAD_DIM
HG_HEAD_DIM = 128
HG_WIDTH = D_MODEL - SB_WIDTH
HG_HEADS = HG_WIDTH // HG_HEAD_DIM
MIX_WIDTH = SB_WIDTH + HG_WIDTH
IN_SPLITS = [SB_WIDTH, SB_WIDTH, SB_WIDTH, HG_WIDTH, HG_WIDTH, HG_WIDTH, HG_WIDTH]
IN_PROJ_WIDTH = sum(IN_SPLITS)
N_GROUPS = 4
EXPERTS_PER_GROUP = 8
N_EXPERTS = N_GROUPS * EXPERTS_PER_GROUP
TOP_K_IN_GROUP = 2
EXPERT_FF = D_MODEL // 2
MOE_BLOCK = 128
EPS = 1e-6

kernel_name = 'hymba_stickbreak_hgrn2_hier_moe'


def rmsnorm(x, gain):
    xf = x.astype(jnp.float32)
    y = xf * lax.rsqrt(jnp.mean(xf * xf, axis=-1, keepdims=True) + EPS)
    return (y * gain.astype(jnp.float32)).astype(x.dtype)


def split_heads(t, n_heads, head_dim):
    b, l, _ = t.shape
    return t.reshape(b, l, n_heads, head_dim).transpose(0, 2, 1, 3)


def merge_heads_norm(o, gain):
    b, h, l, d = o.shape
    o = rmsnorm(o.transpose(0, 2, 1, 3), gain.reshape(h, d))
    return o.reshape(b, l, h * d)


def stick_breaking_attention(q, k, v):
    L = q.shape[2]
    scale = SB_HEAD_DIM ** -0.5
    outs = []
    for blk in range(L // BLOCK):
        t0 = blk * BLOCK
        t1 = t0 + BLOCK
        z = jnp.einsum('bhtd,bhsd->bhts', q[:, :, t0:t1], k[:, :, :t1]).astype(jnp.float32) * scale
        t_pos = jnp.arange(t0, t1)[:, None]
        s_pos = jnp.arange(t1)[None, :]
        valid = (s_pos < t_pos) & (s_pos >= LEAD_PAD)
        log_beta = jax.nn.log_sigmoid(z)
        log_keep = jnp.where(valid, jax.nn.log_sigmoid(-z), 0.0)
        log_tail = lax.cumsum(log_keep, axis=3, reverse=True) - log_keep
        w = jnp.where(valid, jnp.exp(log_beta + log_tail), 0.0)
        outs.append(jnp.einsum('bhts,bhsd->bhtd', w.astype(v.dtype), v[:, :, :t1]))
    return jnp.concatenate(outs, axis=2)


def hgrn2_chunked(q, k, v, log_f):
    b, h, L, dk = q.shape
    dv = v.shape[-1]
    nc = L // BLOCK

    def to_chunks(t):
        return jnp.moveaxis(t.reshape(b, h, nc, BLOCK, t.shape[-1]), 2, 0)

    causal = jnp.tril(jnp.ones((BLOCK, BLOCK), bool))[:, :, None]

    def step(state, inp):
        qc, kc, vc, gc = inp
        bc = jnp.cumsum(gc, axis=2)
        diff = bc[:, :, :, None, :] - bc[:, :, None, :, :]
        decay = jnp.exp(jnp.where(causal, diff, -jnp.inf))
        scores = jnp.einsum('bhtd,bhsd,bhtsd->bhts', qc, kc, decay)
        o = jnp.einsum('bhts,bhsv->bhtv', scores, vc) + jnp.einsum('bhtd,bhdv->bhtv', qc * jnp.exp(bc), state)
        b_last = bc[:, :, -1, :]
        state = jnp.exp(b_last)[..., None] * state + jnp.einsum(
            'bhsd,bhsv->bhdv', kc * jnp.exp(b_last[:, :, None, :] - bc), vc)
        return state, o

    s0 = jnp.zeros((b, h, dk, dv), jnp.float32)
    _, o = lax.scan(step, s0, (to_chunks(q), to_chunks(k), to_chunks(v), to_chunks(log_f)))
    return jnp.moveaxis(o, 0, 2).reshape(b, h, L, dv)


def hierarchical_moe(x2, w_rg, b_rg, w_re, b_re, w_gate, w_up, w_down):
    n_tok = x2.shape[0]
    grp_probs = jax.nn.softmax(jnp.dot(x2, w_rg).astype(jnp.float32) + b_rg.astype(jnp.float32), axis=-1)
    grp = jnp.argmax(grp_probs, axis=-1)
    p_grp = jnp.max(grp_probs, axis=-1)
    exp_logits = (jnp.dot(x2, w_re).astype(jnp.float32) + b_re.astype(jnp.float32)).reshape(
        n_tok, N_GROUPS, EXPERTS_PER_GROUP)
    in_grp = exp_logits[jnp.arange(n_tok), grp]
    top_val, top_idx = lax.top_k(in_grp, TOP_K_IN_GROUP)
    gate = jax.nn.softmax(top_val, axis=-1) * p_grp[:, None]
    expert_id = (grp[:, None] * EXPERTS_PER_GROUP + top_idx).reshape(-1).astype(jnp.int32)
    gate_flat = gate.reshape(-1)
    token_id = jnp.repeat(jnp.arange(n_tok, dtype=jnp.int32), TOP_K_IN_GROUP)
    n_assign = n_tok * TOP_K_IN_GROUP
    n_slots = -(-n_assign // MOE_BLOCK) * MOE_BLOCK + N_EXPERTS * MOE_BLOCK
    n_blocks = n_slots // MOE_BLOCK
    counts = jnp.zeros((N_EXPERTS,), jnp.int32).at[expert_id].add(1)
    padded = (counts + MOE_BLOCK - 1) // MOE_BLOCK * MOE_BLOCK
    padded_end = jnp.cumsum(padded)
    padded_start = padded_end - padded
    start = jnp.cumsum(counts) - counts
    order = jnp.argsort(expert_id)
    sorted_e = expert_id[order]
    dest = padded_start[sorted_e] + jnp.arange(n_assign, dtype=jnp.int32) - start[sorted_e]
    slot_tok = jnp.zeros((n_slots,), jnp.int32).at[dest].set(token_id[order])
    slot_gate = jnp.zeros((n_slots,), jnp.float32).at[dest].set(gate_flat[order])
    block_e = jnp.clip(jnp.searchsorted(padded_end, jnp.arange(n_blocks, dtype=jnp.int32) * MOE_BLOCK,
                                        side='right'), 0, N_EXPERTS - 1)

    def run_block(args):
        tok, g, e = args
        xb = x2[tok]
        hb = jax.nn.silu(xb @ w_gate[e]) * (xb @ w_up[e])
        return (hb @ w_down[e]) * g[:, None].astype(x2.dtype)

    y_blocks = lax.map(run_block, (slot_tok.reshape(n_blocks, MOE_BLOCK),
                                   slot_gate.reshape(n_blocks, MOE_BLOCK), block_e))
    return jnp.zeros_like(x2).at[slot_tok].add(y_blocks.reshape(n_slots, -1))


def setup_inputs(seed: int = 0) -> dict:
    key = jax.random.key(seed)
    ks = jax.random.split(key, 18)
    f32 = jnp.float32

    def nrm(k, shape, scale):
        return jax.random.normal(k, shape, f32) * scale

    return {
        'x': nrm(ks[0], (BATCH, SEQ, D_MODEL), 1.0),
        'meta_tokens': nrm(ks[1], (N_META, D_MODEL), 1.0),
        'lb_logits': nrm(ks[2], (DEPTH + 1, HG_WIDTH), 0.1).at[-1].add(2.0),
        'g_mix': 1.0 + nrm(ks[3], (DEPTH, D_MODEL), 0.02),
        'w_in': nrm(ks[4], (DEPTH, D_MODEL, IN_PROJ_WIDTH), D_MODEL ** -0.5),
        'sb_gain': 1.0 + nrm(ks[5], (DEPTH, SB_WIDTH), 0.02),
        'hg_gain': 1.0 + nrm(ks[6], (DEPTH, HG_WIDTH), 0.02),
        'w_out': nrm(ks[7], (DEPTH, MIX_WIDTH, D_MODEL), MIX_WIDTH ** -0.5),
        'g_ffn': 1.0 + nrm(ks[8], (DEPTH, D_MODEL), 0.02),
        'w_router_group': nrm(ks[9], (DEPTH, D_MODEL, N_GROUPS), D_MODEL ** -0.5),
        'b_router_group': nrm(ks[10], (DEPTH, N_GROUPS), 0.01),
        'w_router_expert': nrm(ks[11], (DEPTH, D_MODEL, N_EXPERTS), D_MODEL ** -0.5),
        'b_router_expert': nrm(ks[12], (DEPTH, N_EXPERTS), 0.01),
        'w_expert_gate': nrm(ks[13], (DEPTH, N_EXPERTS, D_MODEL, EXPERT_FF), D_MODEL ** -0.5),
        'w_expert_up': nrm(ks[14], (DEPTH, N_EXPERTS, D_MODEL, EXPERT_FF), D_MODEL ** -0.5),
        'w_expert_down': nrm(ks[15], (DEPTH, N_EXPERTS, EXPERT_FF, D_MODEL), EXPERT_FF ** -0.5),
        'g_final': 1.0 + nrm(ks[16], (D_MODEL,), 0.02),
    }


def reference(x, meta_tokens, lb_logits, g_mix, w_in, sb_gain, hg_gain, w_out, g_ffn,
              w_router_group, b_router_group, w_router_expert, b_router_expert,
              w_expert_gate, w_expert_up, w_expert_down, g_final):
    b = x.shape[0]
    lead = jnp.zeros((b, LEAD_PAD, D_MODEL), x.dtype)
    meta = jnp.broadcast_to(meta_tokens.astype(x.dtype)[None], (b, N_META, D_MODEL))
    h = jnp.concatenate([lead, meta, x], axis=1)
    L = h.shape[1]
    real = (jnp.arange(L) >= LEAD_PAD)[None, :, None]
    lower_bounds = jnp.cumsum(jax.nn.softmax(lb_logits.astype(jnp.float32), axis=0), axis=0)
    split_idx = np.cumsum(IN_SPLITS)[:-1].tolist()

    for layer in range(DEPTH):
        a = rmsnorm(h, g_mix[layer])
        proj = jnp.einsum('bld,de->ble', a, w_in[layer])
        sb_q, sb_k, sb_v, hg_q, hg_f, hg_i, hg_g = jnp.split(proj, split_idx, axis=-1)

        o_sb = stick_breaking_attention(split_heads(sb_q, SB_HEADS, SB_HEAD_DIM),
                                        split_heads(sb_k, SB_HEADS, SB_HEAD_DIM),
                                        split_heads(sb_v, SB_HEADS, SB_HEAD_DIM))
        o_sb = merge_heads_norm(o_sb, sb_gain[layer]).astype(proj.dtype)

        lb = lower_bounds[layer]
        f_pre = hg_f.astype(jnp.float32)
        log_f = jnp.log(lb + (1.0 - lb) * jax.nn.sigmoid(f_pre))
        k_in = jnp.where(real, (1.0 - lb) * jax.nn.sigmoid(-f_pre), 0.0)
        q_in = jax.nn.silu(hg_q.astype(jnp.float32))
        o_hg = hgrn2_chunked(split_heads(q_in, HG_HEADS, HG_HEAD_DIM),
                             split_heads(k_in, HG_HEADS, HG_HEAD_DIM),
                             split_heads(hg_i.astype(jnp.float32), HG_HEADS, HG_HEAD_DIM),
                             split_heads(log_f, HG_HEADS, HG_HEAD_DIM))
        o_hg = (merge_heads_norm(o_hg, hg_gain[layer]) * jax.nn.silu(hg_g.astype(jnp.float32))).astype(proj.dtype)

        mixed = jnp.concatenate([o_sb, o_hg], axis=-1)
        h = h + jnp.einsum('ble,ed->bld', mixed, w_out[layer])

        m = rmsnorm(h[:, LEAD_PAD:], g_ffn[layer])
        n_pos = m.shape[1]
        y = hierarchical_moe(m.reshape(b * n_pos, D_MODEL), w_router_group[layer], b_router_group[layer],
                             w_router_expert[layer], b_router_expert[layer], w_expert_gate[layer],
                             w_expert_up[layer], w_expert_down[layer])
        h = h + jnp.pad(y.reshape(b, n_pos, D_MODEL), ((0, 0), (LEAD_PAD, 0), (0, 0)))

    out = rmsnorm(h[:, BLOCK:], g_final)
    return out
```

```cpp
#include <hip/hip_runtime.h>
#include <cstdio>
#include <cstdint>

#define MK_PER_PHASE 0

namespace pg8 {
#define PG8_LAS __attribute__((address_space(3)))
typedef unsigned short bf16_t;
typedef short bf16x8 __attribute__((ext_vector_type(8)));
typedef float f32x4 __attribute__((ext_vector_type(4)));
typedef unsigned u32x4 __attribute__((ext_vector_type(4)));
constexpr int BM = 256, BK = 64, HALF = 128, HTB = HALF * BK * 2  , STAGE_BYTES = 8 * HTB, NXCD = 8, WGM = 8;

__host__ __device__ __forceinline__ int lds_byte(int r, int c) { const int st = (r >> 4) * 2 + (c >> 5), rr = r & 15, cc = c & 31, ob = rr * 64 + cc * 2; return st * 1024 + (ob ^ (((ob >> 9) & 1) << 5)); }
__host__ __device__ __forceinline__ void stage_rc(int b, int& R, int& C) { const int st = b / 1024, sb = b % 1024, swz = sb ^ (((sb >> 9) & 1) << 5); R = (st >> 1) * 16 + swz / 64; C = (st & 1) * 32 + (swz % 64) / 2; }
__host__ __device__ __forceinline__ int perm32(int rho) { const int n = rho >> 4, i = rho & 15; return 8 * (i >> 2) + 4 * n + (i & 3); }

struct Unit { int pm, pn, e, rows; };

struct StaticOrder {
    const char* A; const char* Bt; int K, nM, nN, nwg, G, c;
    __device__ void init(const void* A_, const void* Bt_, int M, int N, int K_, int G_, int c_) { A = (const char*)A_; Bt = (const char*)Bt_; K = K_; nM = M / BM; nN = N / BM; nwg = nM * nN; G = G_; c = c_; }
    __device__ bool next(int i, Unit& u) const {
        const long L = (long)i * G + c; if (L >= nwg) return false;
        int wgid = (int)L; { const int q = nwg / NXCD, r = nwg % NXCD, xcd = wgid % NXCD, off = wgid / NXCD; wgid = (xcd < r ? xcd * (q + 1) : r * (q + 1) + (xcd - r) * q) + off; }
        const int nig = WGM * nN, gid = wgid / nig, fm = gid * WGM, gsz = (nM - fm) < WGM ? (nM - fm) : WGM;
        u.pm = fm + ((wgid % nig) % gsz); u.pn = (wgid % nig) / gsz; u.e = 0; u.rows = BM; return true;
    }
    __device__ __forceinline__ const char* a_base(const Unit& u) const { return A + (size_t)u.pm * BM * K * 2; }
    __device__ __forceinline__ const char* b_base(const Unit& u) const { return Bt + (size_t)u.pn * BM * K * 2; }
    __device__ __forceinline__ void a_off(const Unit&, int, const int (&sR)[2], const int (&sC)[2], unsigned (&g)[2][2]) const {
#pragma unroll
        for (int h = 0; h < 2; ++h)
#pragma unroll
            for (int i = 0; i < 2; ++i) g[h][i] = (unsigned)((h * HALF + sR[i]) * K + sC[i]) * 2u;
    }
};

__device__ __forceinline__ unsigned cvt_pk_bf16(float lo, float hi) { unsigned r; asm volatile("v_cvt_pk_bf16_f32 %0, %1, %2" : "=v"(r) : "v"(lo), "v"(hi)); return r; }

template <class Epi, class Sched>
__device__ __forceinline__ void gemm_phase(PG8_LAS unsigned char* lds, const int K, const Sched& S, const Epi& E) {
    const int tid = threadIdx.x, wid = __builtin_amdgcn_readfirstlane(tid >> 6), lane = tid & 63, wr = wid >> 2, wc = wid & 3, fr = lane & 15, fq = lane >> 4;
    const int nt = K / BK;
    unsigned voffB[2]; int sR[2], sC[2];
#pragma unroll
    for (int i = 0; i < 2; ++i) { int R, C; stage_rc(tid * 16 + i * 8192, R, C); sR[i] = R; sC[i] = C; const int Rb = Epi::PERM ? ((R & ~31) + perm32(R & 31)) : R; voffB[i] = (unsigned)(Rb * K + C) * 2u; }
    const size_t kstep = (size_t)(BK * 2);
    const size_t hstep = (size_t)HALF * K * 2;
    const unsigned ldsw = (unsigned)wid * 1024u;
    const int aoff = lds_byte(wr * 64 + fr, fq * 8), boff = lds_byte(wc * 32 + fr, fq * 8);
#define PG8_SA(b, h) (((b) * 2 + (h)) * HTB)
#define PG8_SB(b, h) ((4 + (b) * 2 + (h)) * HTB)
#define PG8_STAGE(bufoff, gbase, voff) do { _Pragma("unroll") for (int _i = 0; _i < 2; ++_i) \
        __builtin_amdgcn_global_load_lds((const unsigned*)((const char*)(gbase) + (voff)[_i]), (PG8_LAS unsigned*)(lds + (bufoff) + ldsw + _i * 8192), 16, 0, 0); } while (0)
#define PG8_LDA(dst, b, h) do { _Pragma("unroll") for (int m = 0; m < 4; ++m) _Pragma("unroll") for (int k = 0; k < 2; ++k) dst[m][k] = *(const PG8_LAS bf16x8*)(lds + PG8_SA(b, h) + aoff + m * 2048 + k * 1024); } while (0)
#define PG8_LDB(dst, b, h) do { _Pragma("unroll") for (int n = 0; n < 2; ++n) _Pragma("unroll") for (int k = 0; k < 2; ++k) dst[n][k] = *(const PG8_LAS bf16x8*)(lds + PG8_SB(b, h) + boff + n * 2048 + k * 1024); } while (0)
#define PG8_MMA(ai, bj, At, Bt) do { __builtin_amdgcn_s_setprio(1); _Pragma("unroll") for (int m = 0; m < 4; ++m) _Pragma("unroll") for (int n = 0; n < 2; ++n) _Pragma("unroll") for (int k = 0; k < 2; ++k) \
        acc[ai][bj][m][n] = __builtin_amdgcn_mfma_f32_16x16x32_bf16(Bt[n][k], At[m][k], acc[ai][bj][m][n], 0, 0, 0); __builtin_amdgcn_s_setprio(0); } while (0)
#define PG8_WAIT_V(n) asm volatile("s_waitcnt vmcnt(" #n ")" ::: "memory")
#define PG8_WAIT_L(n) asm volatile("s_waitcnt lgkmcnt(" #n ")" ::: "memory")
#define PG8_BAR __builtin_amdgcn_s_barrier()
#define PG8_SCHED __builtin_amdgcn_sched_barrier(0)
    Unit cur, nxt; int ui = 0;
    if (!S.next(0, cur)) return;
    f32x4 acc[2][2][4][2];
#pragma unroll
    for (int a = 0; a < 2; ++a)
#pragma unroll
        for (int b = 0; b < 2; ++b)
#pragma unroll
            for (int m = 0; m < 4; ++m)
#pragma unroll
                for (int n = 0; n < 2; ++n) acc[a][b][m][n] = (f32x4){0.f, 0.f, 0.f, 0.f};
    bf16x8 At[4][2], B0[2][2], B1[2][2];
    unsigned gc[2][2], gn[2][2];
    S.a_off(cur, 0, sR, sC, gc);
#pragma unroll
    for (int h = 0; h < 2; ++h)
#pragma unroll
        for (int i = 0; i < 2; ++i) gn[h][i] = gc[h][i];
    const char* cA = S.a_base(cur); const char* cB = S.b_base(cur);
    PG8_STAGE(PG8_SB(0, 0), cB, voffB); PG8_STAGE(PG8_SA(0, 0), cA, gc[0]); PG8_STAGE(PG8_SB(0, 1), cB + hstep, voffB); PG8_STAGE(PG8_SA(0, 1), cA, gc[1]);
    if (wr == 1) PG8_BAR;
    PG8_WAIT_V(4); PG8_BAR;
    PG8_STAGE(PG8_SB(1, 0), cB + kstep, voffB); PG8_STAGE(PG8_SA(1, 0), cA + kstep, gc[0]); PG8_STAGE(PG8_SB(1, 1), cB + hstep + kstep, voffB);
    PG8_WAIT_V(6); PG8_BAR;
    for (;;) {
        const bool has_next = S.next(ui + 1, nxt);
        const char* nA = has_next ? S.a_base(nxt) : cA; const char* nB = has_next ? S.b_base(nxt) : cB;
        for (int t = 0; t < nt; t += 2) {
            const bool last = (t == nt - 2);
            const char* a1 = cA + (size_t)(t + 1) * kstep;
            const char* a2 = last ? nA : cA + (size_t)(t + 2) * kstep; const char* b2 = last ? nB : cB + (size_t)(t + 2) * kstep;
            const char* a3 = a2 + kstep; const char* b3 = b2 + kstep;
            if (last && has_next) S.a_off(nxt, ui + 1, sR, sC, gn);
            unsigned g2[2][2];
#pragma unroll
            for (int h = 0; h < 2; ++h)
#pragma unroll
                for (int i = 0; i < 2; ++i) g2[h][i] = last ? gn[h][i] : gc[h][i];
            PG8_LDB(B0, 0, 0); PG8_SCHED; PG8_LDA(At, 0, 0); PG8_STAGE(PG8_SA(1, 1), a1, gc[1]);
            PG8_WAIT_L(8); PG8_BAR; PG8_WAIT_L(0); PG8_MMA(0, 0, At, B0); PG8_BAR; PG8_SCHED;
            PG8_LDB(B1, 0, 1); PG8_STAGE(PG8_SB(0, 0), b2, voffB);
            PG8_BAR; PG8_WAIT_L(0); PG8_MMA(0, 1, At, B1); PG8_BAR;
            PG8_LDA(At, 0, 1); PG8_STAGE(PG8_SA(0, 0), a2, g2[0]);
            PG8_BAR; PG8_WAIT_L(0); PG8_MMA(1, 0, At, B0); PG8_BAR; PG8_SCHED;
            PG8_STAGE(PG8_SB(0, 1), b2 + hstep, voffB);
            PG8_WAIT_V(6); PG8_BAR; PG8_MMA(1, 1, At, B1); PG8_BAR;
            PG8_LDB(B0, 1, 0); PG8_SCHED; PG8_LDA(At, 1, 0); PG8_STAGE(PG8_SA(0, 1), a2, g2[1]);
            PG8_WAIT_L(8); PG8_BAR; PG8_WAIT_L(0); PG8_MMA(0, 0, At, B0); PG8_BAR; PG8_SCHED;
            PG8_LDB(B1, 1, 1); PG8_STAGE(PG8_SB(1, 0), b3, voffB);
            PG8_BAR; PG8_WAIT_L(0); PG8_MMA(0, 1, At, B1); PG8_BAR;
            PG8_LDA(At, 1, 1); PG8_STAGE(PG8_SA(1, 0), a3, g2[0]);
            PG8_BAR; PG8_WAIT_L(0); PG8_MMA(1, 0, At, B0); PG8_BAR; PG8_SCHED;
            PG8_STAGE(PG8_SB(1, 1), b3 + hstep, voffB);
            PG8_WAIT_V(6); PG8_BAR; PG8_MMA(1, 1, At, B1); PG8_BAR;
        }
        E(acc, cur, ui, wr, wc, fr, fq);
        if (!has_next) break;
#pragma unroll
        for (int a = 0; a < 2; ++a)
#pragma unroll
            for (int b = 0; b < 2; ++b)
#pragma unroll
                for (int m = 0; m < 4; ++m)
#pragma unroll
                    for (int n = 0; n < 2; ++n) acc[a][b][m][n] = (f32x4){0.f, 0.f, 0.f, 0.f};
        cur = nxt; cA = nA; cB = nB; ++ui;
#pragma unroll
        for (int h = 0; h < 2; ++h)
#pragma unroll
            for (int i = 0; i < 2; ++i) gc[h][i] = gn[h][i];
    }
    PG8_WAIT_V(0);
    if (wr == 0) PG8_BAR;
    PG8_BAR;
#undef PG8_SA
#undef PG8_SB
#undef PG8_STAGE
#undef PG8_LDA
#undef PG8_LDB
#undef PG8_MMA
#undef PG8_WAIT_V
#undef PG8_WAIT_L
#undef PG8_BAR
#undef PG8_SCHED
}
}

constexpr int NWAVES = 8;
constexpr int NB = 8, SEQ = 4096, D = 1024, NTOK = NB * SEQ, NPROJ = 3584, NMETA = 16;
constexpr int SBH = 8, SBD = 64, HGH = 4, HGD = 128;
constexpr int NE = 32, FF = 512, LCAP = NTOK;
constexpr float EPS = 1e-6f;
constexpr float QSCALE = 0.125f * 1.4426950408889634f;

constexpr size_t MiB = 1u << 20;
constexpr size_t WS_CTL = 0, CTL_ZERO_BYTES = 1 * MiB;
constexpr size_t WS_WIN = 1 * MiB, WS_WOUT = 8 * MiB, WS_WRT = 10 * MiB, WS_WGU = 11 * MiB, WS_WDN = 75 * MiB;
constexpr size_t WS_META = 107 * MiB;
constexpr size_t WS_RSTD1 = 108 * MiB;
constexpr size_t WS_LTOK = 109 * MiB, WS_LGATE = 113 * MiB, WS_LRSTD = 117 * MiB;
constexpr size_t WS_XB = 121 * MiB;
constexpr size_t WS_MIXED = WS_XB, WS_HBUF = WS_XB;
constexpr size_t WS_QKV = 193 * MiB, WS_HQ = 289 * MiB, WS_HG = 321 * MiB, WS_HV = 385 * MiB, WS_HGS = 417 * MiB;
constexpr size_t WS_H = 193 * MiB, WS_HB16 = 321 * MiB;
constexpr size_t WS_Y0 = 321 * MiB, WS_Y1 = 385 * MiB;
constexpr size_t WS_END = 449 * MiB;
constexpr int CW_TMO = 0, CW_CODE = 1, CW_BAR = 4096, CW_CNT = 8192;

constexpr int RING_OFF = 0, RING_BYTES = 131072;
constexpr int LIST_OFF = RING_BYTES, LIST_BYTES = 16384;
constexpr int MISC_OFF = LIST_OFF + LIST_BYTES;
constexpr int LDS_BYTES = MISC_OFF + 1024;
static_assert(LDS_BYTES <= 160 * 1024, "LDS");

#define GAS __attribute__((address_space(1)))
#define LAS __attribute__((address_space(3)))
typedef unsigned short bf16;
typedef unsigned v4u __attribute__((ext_vector_type(4)));
typedef unsigned v2u __attribute__((ext_vector_type(2)));
typedef float f32x4 __attribute__((ext_vector_type(4)));
typedef short bf16x8 __attribute__((ext_vector_type(8)));
typedef GAS unsigned gu32;
#define RLX_AGENT __ATOMIC_RELAXED, __HIP_MEMORY_SCOPE_AGENT
#define LDS_WAIT() asm volatile("s_waitcnt lgkmcnt(0)" ::: "memory")
__device__ __forceinline__ unsigned f2bf(float f) { unsigned u = __builtin_bit_cast(unsigned, f); return (u + 0x7fffu + ((u >> 16) & 1u)) >> 16; }
__device__ __forceinline__ unsigned pk2(float lo, float hi) { return f2bf(lo) | (f2bf(hi) << 16); }
__device__ __forceinline__ float bflo(unsigned u) { return __builtin_bit_cast(float, u << 16); }
__device__ __forceinline__ float bfhi(unsigned u) { return __builtin_bit_cast(float, u & 0xffff0000u); }
__device__ __forceinline__ float silu_f(float x) { return x * __builtin_amdgcn_rcpf(1.0f + __expf(-x)); }
__device__ __forceinline__ float wave_sum(float v) {
#pragma unroll
    for (int o = 1; o < 64; o <<= 1) v += __shfl_xor(v, o);
    return v;
}

#define XB_TMO      128
#define XB_XCNT(j)  (256  + 64 * (j))
#define XB_XSUB(j)  (1280 + 64 * (j))
#define XB_XGEN(j)  (2304 + 64 * (j))
#define XB_TOP      3328
#define XB_TOPGEN   3392
#define XCD_BAR_WORDS 3456
#define XB_SPIN_CAP (1u << 18)
__device__ __forceinline__ unsigned xb_ld(unsigned* p)              { return __hip_atomic_load(p, __ATOMIC_RELAXED, __HIP_MEMORY_SCOPE_AGENT); }
__device__ __forceinline__ unsigned xb_add(unsigned* p, unsigned v) { return __hip_atomic_fetch_add(p, v, __ATOMIC_RELAXED, __HIP_MEMORY_SCOPE_AGENT); }
__device__ __forceinline__ unsigned xb_xcc_id() { return (unsigned)__builtin_amdgcn_s_getreg((3 << 11) | 20) & 0xFu; }
#define XB_SPIN(cond, bar) do { unsigned _sp = 0; while (cond) { __builtin_amdgcn_s_sleep(1); \
    if ((++_sp & 255u) == 0u) { if (xb_ld(&(bar)[XB_TMO])) break; if (_sp > XB_SPIN_CAP) { atomicAdd(&(bar)[XB_TMO], 1u); break; } } } } while (0)
struct XcdBarrier { unsigned* bar; unsigned x; volatile LAS unsigned* st; };
__device__ __forceinline__ XcdBarrier xcd_barrier_post(unsigned* bar, volatile LAS unsigned* st) {
    XcdBarrier b; b.bar = bar; b.x = xb_xcc_id(); b.st = st;
    if (threadIdx.x == 0) (void)xb_add(&bar[XB_XCNT(b.x)], 1u);
    return b;
}
__device__ __forceinline__ void xcd_barrier_complete(unsigned* bar, unsigned x, unsigned& nloc, unsigned& nx) {
    const unsigned G = gridDim.x * gridDim.y * gridDim.z;
    unsigned sum, cnt, mine, sp = 0u;
    for (;;) {
        sum = 0u; cnt = 0u; mine = 0u;
#pragma unroll
        for (unsigned j = 0; j < 16; ++j) { const unsigned c = xb_ld(&bar[XB_XCNT(j)]); sum += c; cnt += (c > 0u) ? 1u : 0u; mine = (j == x) ? c : mine; }
        if (sum == G) break;
        __builtin_amdgcn_s_sleep(1);
        if ((++sp & 255u) == 0u) { if (xb_ld(&bar[XB_TMO])) break; if (sp > XB_SPIN_CAP) { atomicAdd(&bar[XB_TMO], 1u); break; } }
    }
    nloc = mine > 0u ? mine : 1u; nx = cnt > 0u ? cnt : 1u;
}
__device__ __forceinline__ void xcd_barrier(const XcdBarrier& b) {
    asm volatile("s_waitcnt vmcnt(0)" ::: "memory");
    __syncthreads();
    if (threadIdx.x == 0) {
        unsigned* bar = b.bar;
        __builtin_amdgcn_s_waitcnt(0);
        unsigned nloc = b.st[0], nx = b.st[1];
        if (nloc == 0u) { xcd_barrier_complete(bar, b.x, nloc, nx); b.st[0] = nloc; b.st[1] = nx; }
        const unsigned old = xb_add(&bar[XB_XSUB(b.x)], 1u);
        const unsigned gen = old / nloc;
        if (old + 1u == (gen + 1u) * nloc) {
            __builtin_amdgcn_fence(__ATOMIC_RELEASE, "agent");
            asm volatile("s_waitcnt vmcnt(0)" ::: "memory");
            const unsigned og = xb_add(&bar[XB_TOP], 1u);
            const unsigned tg = og / nx;
            if (og + 1u == (tg + 1u) * nx) xb_add(&bar[XB_TOPGEN], 1u);
            else XB_SPIN(xb_ld(&bar[XB_TOPGEN]) == tg, bar);
            __builtin_amdgcn_fence(__ATOMIC_ACQUIRE, "agent");
            xb_add(&bar[XB_XGEN(b.x)], 1u);
            asm volatile("s_waitcnt vmcnt(0)" ::: "memory");
        } else {
            XB_SPIN(xb_ld(&bar[XB_XGEN(b.x)]) == gen, bar);
            __builtin_amdgcn_fence(__ATOMIC_ACQUIRE, "agent");
            asm volatile("s_waitcnt vmcnt(0)" ::: "memory");
        }
    }
    __syncthreads();
}

struct Args { const float* in[17]; float* out; unsigned char* ws; int ph_lo, ph_hi; };
struct Frame {
    LAS unsigned char* lds; volatile LAS unsigned* MISC; gu32* ctl; unsigned char* ws;
    int tid, lane, wave, G, bx;
    const float *x, *meta, *lb_logits, *g_mix, *w_in, *sb_gain, *hg_gain, *w_out, *g_ffn, *w_rg, *b_rg, *w_re, *b_re, *w_gate, *w_up, *w_down, *g_final;
    float* out;
};

__device__ __forceinline__ void p0_transpose_item(const float* W, int ldw, int srcc0, int k0, bf16* WT, int Kd, int dstr0, const float* gain, LAS float* scr, int lane) {
#pragma unroll 8
    for (int i = 0; i < 32; ++i) { const int kk = 2 * i + (lane >> 5); float v = W[(size_t)(k0 + kk) * ldw + srcc0 + (lane & 31)]; if (gain) v *= gain[k0 + kk]; scr[kk * 33 + (lane & 31)] = v; }
    LDS_WAIT(); asm volatile("" ::: "memory");
    const int c = lane & 7;
#pragma unroll
    for (int j = 0; j < 4; ++j) { const int n = (lane >> 3) + 8 * j; const LAS float* s = scr + (8 * c) * 33 + n;
        v4u o; o.x = pk2(s[0 * 33], s[1 * 33]); o.y = pk2(s[2 * 33], s[3 * 33]); o.z = pk2(s[4 * 33], s[5 * 33]); o.w = pk2(s[6 * 33], s[7 * 33]);
        *(GAS v4u*)(WT + (size_t)(dstr0 + n) * Kd + k0 + 8 * c) = o; }
    LDS_WAIT(); asm volatile("" ::: "memory");
}
__device__ __forceinline__ void p0_prologue(Frame& F) {
    unsigned char* ws = F.ws;
    const int gw = F.bx * NWAVES + F.wave, NGW = F.G * NWAVES;
    {
        LAS float* am = (LAS float*)(F.lds);
        LAS float* red = (LAS float*)(F.lds + 65536);
        for (int r = F.wave * 2; r < F.wave * 2 + 2; ++r) {
            const GAS f32x4* xr = (const GAS f32x4*)(F.meta + (size_t)r * D) + F.lane; f32x4 v[4]; float s = 0.f;
#pragma unroll
            for (int j = 0; j < 4; ++j) { v[j] = xr[64 * j]; s += (v[j].x * v[j].x + v[j].y * v[j].y) + (v[j].z * v[j].z + v[j].w * v[j].w); }
            const float rstd = 1.0f / sqrtf(wave_sum(s) * (1.f / D) + EPS);
#pragma unroll
            for (int j = 0; j < 4; ++j) { const int k = 4 * F.lane + 256 * j; const f32x4 g = *(const GAS f32x4*)(F.g_mix + k);
                am[r * D + k + 0] = v[j].x * rstd * g.x; am[r * D + k + 1] = v[j].y * rstd * g.y; am[r * D + k + 2] = v[j].z * rstd * g.z; am[r * D + k + 3] = v[j].w * rstd * g.w; }
        }
        __syncthreads();
        for (int cb = F.bx; cb < NPROJ / 14; cb += F.G) {
            if (F.tid < 448) { const int c = F.tid % 14, ks = F.tid / 14, col = cb * 14 + c; float a[16];
#pragma unroll
                for (int r = 0; r < 16; ++r) a[r] = 0.f;
                for (int k = ks * 32; k < ks * 32 + 32; ++k) { const float w = F.w_in[(size_t)k * NPROJ + col];
#pragma unroll
                    for (int r = 0; r < 16; ++r) a[r] += am[r * D + k] * w; }
#pragma unroll
                for (int r = 0; r < 16; ++r) red[(ks * 14 + c) * 16 + r] = a[r]; }
            __syncthreads();
            if (F.tid < 224) { const int c = F.tid / 16, r = F.tid % 16; float s = 0.f;
                for (int ks = 0; ks < 32; ++ks) s += red[(ks * 14 + c) * 16 + r];
                ((float*)(ws + WS_META))[r * NPROJ + cb * 14 + c] = s; }
            __syncthreads();
        }
    }
    if (F.bx == (1 % F.G)) { float* LB = (float*)(ws + WS_META + 256 * 1024); const float a = F.lb_logits[F.tid], b = F.lb_logits[512 + F.tid], m = fmaxf(a, b), ea = __expf(a - m), eb = __expf(b - m); LB[F.tid] = ea / (ea + eb); }
    for (int i = F.bx * 512 + F.tid; i < 48 * D; i += F.G * 512) { const int e = i / D, k = i % D; float v = 0.f; if (e < 4) v = F.w_rg[k * 4 + e]; else if (e < 36) v = F.w_re[k * 32 + (e - 4)]; ((bf16*)(ws + WS_WRT))[i] = (bf16)f2bf(v * F.g_ffn[k]); }
    {
        LAS float* scr = (LAS float*)(F.lds + RING_OFF + F.wave * 16384);
        constexpr int I_IN = (D / 64) * (NPROJ / 32), I_OUT = (D / 64) * (D / 32), I_GU = NE * (D / 64) * (1024 / 32), I_DN = NE * (FF / 64) * (D / 32);
        constexpr int NITEMS = I_IN + I_OUT + I_GU + I_DN;
        for (int it = gw; it < NITEMS; it += NGW) {
            int r = it;
            if (r < I_IN) { const int nb = r % (NPROJ / 32), kb = r / (NPROJ / 32); p0_transpose_item(F.w_in, NPROJ, 32 * nb, 64 * kb, (bf16*)(ws + WS_WIN), D, 32 * nb, F.g_mix, scr, F.lane); continue; } r -= I_IN;
            if (r < I_OUT) { const int nb = r % (D / 32), kb = r / (D / 32); p0_transpose_item(F.w_out, D, 32 * nb, 64 * kb, (bf16*)(ws + WS_WOUT), D, 32 * nb, nullptr, scr, F.lane); continue; } r -= I_OUT;
            if (r < I_GU) { const int e = r / (16 * 32), q = r % (16 * 32), nb = q % 32, kb = q / 32, pn = nb / 8, half = (nb % 8) / 4, i0 = (nb % 4) * 32;
                const float* src = (half ? F.w_up : F.w_gate) + (size_t)e * D * FF;
                p0_transpose_item(src, FF, 128 * pn + i0, 64 * kb, (bf16*)(ws + WS_WGU) + (size_t)e * 1024 * D, D, 32 * nb, F.g_ffn, scr, F.lane); continue; } r -= I_GU;
            { const int e = r / (8 * 32), q = r % (8 * 32), nb = q % 32, kb = q / 32;
                p0_transpose_item(F.w_down + (size_t)e * FF * D, D, 32 * nb, 64 * kb, (bf16*)(ws + WS_WDN) + (size_t)e * D * FF, FF, 32 * nb, nullptr, scr, F.lane); }
        }
    }
    for (int m = gw; m < NTOK; m += NGW) {
        const GAS f32x4* xr = (const GAS f32x4*)(F.x + (size_t)m * D) + F.lane; f32x4 v[4]; float s = 0.f;
#pragma unroll
        for (int j = 0; j < 4; ++j) { v[j] = xr[64 * j]; s += (v[j].x * v[j].x + v[j].y * v[j].y) + (v[j].z * v[j].z + v[j].w * v[j].w); }
        s = wave_sum(s);
        if (F.lane == 0) ((float*)(ws + WS_RSTD1))[m] = 1.0f / sqrtf(s * (1.f / D) + EPS);
        GAS v2u* o8 = (GAS v2u*)((bf16*)(ws + WS_XB) + (size_t)m * D) + F.lane;
#pragma unroll
        for (int j = 0; j < 4; ++j) { v2u w; w.x = pk2(v[j].x, v[j].y); w.y = pk2(v[j].z, v[j].w); o8[64 * j] = w; }
    }
}

struct EpiInProj {
    static constexpr bool PERM = true;
    const float* rstd; const float* LB; bf16* QKV; bf16* HQ; float* HG; bf16* HV; bf16* HGS;
    __device__ __forceinline__ void operator()(const pg8::f32x4 (&acc)[2][2][4][2], const pg8::Unit& u, int, int wr, int wc, int fr, int fq) const {
        const int row0 = u.pm * 256 + wr * 64 + fr, cl = wc * 32 + 8 * fq;
        const int kind = u.pn < 6 ? (u.pn < 2 ? 0 : 1) : (u.pn < 8 ? 2 : (u.pn < 10 ? 3 : (u.pn < 12 ? 1 : 2)));
        bf16* dst; int ldc, c0;
        if (u.pn < 6) { dst = QKV; ldc = 1536; c0 = u.pn * 256; } else if (u.pn < 8) { dst = HQ; ldc = 512; c0 = (u.pn - 6) * 256; }
        else if (u.pn < 10) { dst = nullptr; ldc = 512; c0 = (u.pn - 8) * 256; } else if (u.pn < 12) { dst = HV; ldc = 512; c0 = (u.pn - 10) * 256; } else { dst = HGS; ldc = 512; c0 = (u.pn - 12) * 256; }
        f32x4 lbv[2][2];
        if (kind == 3) {
#pragma unroll
            for (int bj = 0; bj < 2; ++bj)
#pragma unroll
                for (int n = 0; n < 2; ++n) lbv[bj][n] = *(const f32x4*)(LB + c0 + bj * 128 + cl + 4 * n);
        }
#pragma unroll
        for (int ai = 0; ai < 2; ++ai)
#pragma unroll
            for (int m = 0; m < 4; ++m) {
                const int row = row0 + ai * 128 + m * 16; const float rs = rstd[row];
#pragma unroll
                for (int bj = 0; bj < 2; ++bj) {
                    f32x4 v0 = acc[ai][bj][m][0] * rs, v1 = acc[ai][bj][m][1] * rs;
                    const size_t off = (size_t)row * ldc + c0 + bj * 128 + cl;
                    if (kind == 3) {
#pragma unroll
                        for (int j = 0; j < 4; ++j) { const float l0 = lbv[bj][0][j], l1 = lbv[bj][1][j];
                            v0[j] = __logf(l0 + (1.f - l0) * __builtin_amdgcn_rcpf(1.f + __expf(-v0[j]))); v1[j] = __logf(l1 + (1.f - l1) * __builtin_amdgcn_rcpf(1.f + __expf(-v1[j]))); }
                        *(f32x4*)(HG + off) = v0; *(f32x4*)(HG + off + 4) = v1;
                    } else {
                        if (kind == 0) { v0 = v0 * QSCALE; v1 = v1 * QSCALE; }
                        if (kind == 2) {
#pragma unroll
                            for (int j = 0; j < 4; ++j) { v0[j] = silu_f(v0[j]); v1[j] = silu_f(v1[j]); } }
                        pg8::u32x4 w; w.x = pg8::cvt_pk_bf16(v0[0], v0[1]); w.y = pg8::cvt_pk_bf16(v0[2], v0[3]); w.z = pg8::cvt_pk_bf16(v1[0], v1[1]); w.w = pg8::cvt_pk_bf16(v1[2], v1[3]);
                        *(pg8::u32x4*)(dst + off) = w;
                    }
                }
            }
    }
};
struct EpiOutProj {
    static constexpr bool PERM = true;
    const float* x; float* H; bf16* HB16;
    __device__ __forceinline__ void operator()(const pg8::f32x4 (&acc)[2][2][4][2], const pg8::Unit& u, int, int wr, int wc, int fr, int fq) const {
        const int row0 = u.pm * 256 + wr * 64 + fr, col0 = u.pn * 256 + wc * 32 + 8 * fq;
#pragma unroll
        for (int ai = 0; ai < 2; ++ai)
#pragma unroll
            for (int m = 0; m < 4; ++m) {
                const size_t ro = (size_t)(row0 + ai * 128 + m * 16) * D + col0;
#pragma unroll
                for (int bj = 0; bj < 2; ++bj) {
                    const size_t off = ro + bj * 128;
                    const f32x4 v0 = acc[ai][bj][m][0] + *(const f32x4*)(x + off), v1 = acc[ai][bj][m][1] + *(const f32x4*)(x + off + 4);
                    *(f32x4*)(H + off) = v0; *(f32x4*)(H + off + 4) = v1;
                    pg8::u32x4 w; w.x = pg8::cvt_pk_bf16(v0[0], v0[1]); w.y = pg8::cvt_pk_bf16(v0[2], v0[3]); w.z = pg8::cvt_pk_bf16(v1[0], v1[1]); w.w = pg8::cvt_pk_bf16(v1[2], v1[3]);
                    *(pg8::u32x4*)(HB16 + off) = w;
                }
            }
    }
};
struct EpiGateUp {
    static constexpr bool PERM = true;
    const LAS float* lrstd; bf16* HBUF;
    __device__ __forceinline__ void operator()(const pg8::f32x4 (&acc)[2][2][4][2], const pg8::Unit& u, int ord, int wr, int wc, int fr, int fq) const {
        const int rl0 = wr * 64 + fr, col0 = u.pn * 128 + wc * 32 + 8 * fq;
#pragma unroll
        for (int ai = 0; ai < 2; ++ai)
#pragma unroll
            for (int m = 0; m < 4; ++m) {
                const int rl = rl0 + ai * 128 + m * 16; const float rs = lrstd[ord * 256 + rl];
                const f32x4 g0 = acc[ai][0][m][0] * rs, g1 = acc[ai][0][m][1] * rs, u0 = acc[ai][1][m][0] * rs, u1 = acc[ai][1][m][1] * rs;
                float h[8];
#pragma unroll
                for (int j = 0; j < 4; ++j) { h[j] = silu_f(g0[j]) * u0[j]; h[4 + j] = silu_f(g1[j]) * u1[j]; }
                pg8::u32x4 w; w.x = pg8::cvt_pk_bf16(h[0], h[1]); w.y = pg8::cvt_pk_bf16(h[2], h[3]); w.z = pg8::cvt_pk_bf16(h[4], h[5]); w.w = pg8::cvt_pk_bf16(h[6], h[7]);
                *(pg8::u32x4*)(HBUF + (size_t)(u.pm * 256 + rl) * FF + col0) = w;
            }
    }
};
struct EpiDown {
    static constexpr bool PERM = true;
    const LAS unsigned* ltok; const LAS float* lgate; bf16* Y0; bf16* Y1;
    __device__ __forceinline__ void operator()(const pg8::f32x4 (&acc)[2][2][4][2], const pg8::Unit& u, int ord, int wr, int wc, int fr, int fq) const {
        const int rl0 = wr * 64 + fr, col0 = u.pn * 256 + wc * 32 + 8 * fq;
#pragma unroll
        for (int ai = 0; ai < 2; ++ai)
#pragma unroll
            for (int m = 0; m < 4; ++m) {
                const int rl = rl0 + ai * 128 + m * 16; const unsigned tp = ltok[ord * 256 + rl]; const float gt = lgate[ord * 256 + rl];
                if (!(tp & 0x80000000u)) {
                    bf16* yb = ((tp >> 30) & 1u) ? Y1 : Y0; const size_t ro = (size_t)(tp & 0xffffu) * D + col0;
#pragma unroll
                    for (int bj = 0; bj < 2; ++bj) { const f32x4 v0 = acc[ai][bj][m][0] * gt, v1 = acc[ai][bj][m][1] * gt;
                        pg8::u32x4 w; w.x = pg8::cvt_pk_bf16(v0[0], v0[1]); w.y = pg8::cvt_pk_bf16(v0[2], v0[3]); w.z = pg8::cvt_pk_bf16(v1[0], v1[1]); w.w = pg8::cvt_pk_bf16(v1[2], v1[3]);
                        *(pg8::u32x4*)(yb + ro + bj * 128) = w; }
                }
            }
    }
};
template <bool GATHER> struct MoeOrder {
    const LAS int* tstart; const LAS int* cntl; const LAS unsigned* ltok; const char* A; const char* Bt; int K, G, c, nunits;
    __device__ bool next(int i, pg8::Unit& u) const {
        const int L = i * G + c; if (L >= nunits) return false;
        const int rt = L >> 2; int e = 0;
        while (e < NE - 1 && tstart[e + 1] <= rt) ++e;
        e = __builtin_amdgcn_readfirstlane(e);
        u.pm = rt; u.pn = L & 3; u.e = e; const int left = cntl[e] - (rt - tstart[e]) * 256; u.rows = __builtin_amdgcn_readfirstlane(left < 256 ? left : 256); return true;
    }
    __device__ __forceinline__ const char* a_base(const pg8::Unit& u) const { return GATHER ? A : A + (size_t)u.pm * 256 * K * 2; }
    __device__ __forceinline__ const char* b_base(const pg8::Unit& u) const { return Bt + ((size_t)u.e * 1024 + (size_t)u.pn * 256) * K * 2; }
    __device__ __forceinline__ void a_off(const pg8::Unit&, int ord, const int (&sR)[2], const int (&sC)[2], unsigned (&g)[2][2]) const {
#pragma unroll
        for (int h = 0; h < 2; ++h)
#pragma unroll
            for (int i = 0; i < 2; ++i) {
                if (GATHER) g[h][i] = ((ltok[ord * 256 + h * 128 + sR[i]] & 0xffffu) * (unsigned)K + (unsigned)sC[i]) * 2u;
                else g[h][i] = (unsigned)((h * 128 + sR[i]) * K + sC[i]) * 2u;
            }
    }
};
__device__ __forceinline__ int moe_setup(Frame& F, int which  ) {
    volatile LAS int* M = (volatile LAS int*)F.MISC;
    if (F.tid < NE) M[40 + F.tid] = (int)__hip_atomic_load(F.ctl + CW_CNT + 64 * F.tid, RLX_AGENT);
    __syncthreads();
    if (F.tid == 0) { int s = 0; for (int e = 0; e < NE; ++e) { M[e] = s; s += (M[40 + e] + 255) >> 8; } M[NE] = s; }
    __syncthreads();
    const int nrt = M[NE], nunits = nrt * 4;
    LAS unsigned* ltok = (LAS unsigned*)(F.lds + LIST_OFF); LAS float* lval = (LAS float*)(F.lds + LIST_OFF + 8192);
    const unsigned* LT = (const unsigned*)(F.ws + WS_LTOK); const float* LV = (const float*)(F.ws + (which ? WS_LGATE : WS_LRSTD));
    for (int i = 0; i < 8; ++i) {
        const int L = i * F.G + F.bx; if (L >= nunits) break;
        const int rt = L >> 2; int e = 0; while (e < NE - 1 && M[e + 1] <= rt) ++e;
        if (F.tid < 256) { const int idx = (rt - M[e]) * 256 + F.tid; const bool ok = idx < M[40 + e];
            ltok[i * 256 + F.tid] = ok ? LT[(size_t)e * LCAP + idx] : 0x80000000u; lval[i * 256 + F.tid] = ok ? LV[(size_t)e * LCAP + idx] : 0.f; }
    }
    __syncthreads();
    return nunits;
}

__device__ __forceinline__ void p2_attention_naive(Frame& F) {
    const bf16* QKV = (const bf16*)(F.ws + WS_QKV); const float* MP = (const float*)(F.ws + WS_META); bf16* MIX = (bf16*)(F.ws + WS_MIXED);
    for (int id = F.bx * 512 + F.tid; id < NB * SBH * SEQ; id += F.G * 512) {
        const int t = id % SEQ, h = (id / SEQ) % SBH, b = id / (SEQ * SBH); const size_t row = (size_t)b * SEQ + t;
        float o[64];
        const v4u* qp = (const v4u*)(QKV + row * 1536 + h * 64);
#pragma unroll
        for (int d = 0; d < 64; ++d) o[d] = 0.f;
        float R = 0.f;
        for (int s = t - 1; s >= -NMETA; --s) {
            float z = 0.f;
            if (s >= 0) { const v4u* kp = (const v4u*)(QKV + ((size_t)b * SEQ + s) * 1536 + 512 + h * 64);
#pragma unroll
                for (int i = 0; i < 8; ++i) { const v4u w = kp[i]; const v4u qq = qp[i]; z += bflo(qq.x) * bflo(w.x) + bfhi(qq.x) * bfhi(w.x) + bflo(qq.y) * bflo(w.y) + bfhi(qq.y) * bfhi(w.y) + bflo(qq.z) * bflo(w.z) + bfhi(qq.z) * bfhi(w.z) + bflo(qq.w) * bflo(w.w) + bfhi(qq.w) * bfhi(w.w);
                    if ((i & 3) == 3) asm volatile("" ::: "memory"); }
            } else { const f32x4* kp = (const f32x4*)(MP + (size_t)(NMETA + s) * NPROJ + 512 + h * 64);
#pragma unroll
                for (int i = 0; i < 16; ++i) { const f32x4 w = kp[i]; const v4u qq = qp[i >> 1]; const unsigned qa = (i & 1) ? qq.z : qq.x, qb = (i & 1) ? qq.w : qq.y; z += bflo(qa) * w.x + bfhi(qa) * w.y + bflo(qb) * w.z + bfhi(qb) * w.w; if ((i & 3) == 3) asm volatile("" ::: "memory"); } }
            const float L = __log2f(1.0f + __builtin_amdgcn_exp2f(-fabsf(z)));
            const float lk = -(fmaxf(z, 0.f) + L), lbt = fminf(z, 0.f) - L;
            const float w = __builtin_amdgcn_exp2f(lbt + R);
            if (s >= 0) { const v4u* vp = (const v4u*)(QKV + ((size_t)b * SEQ + s) * 1536 + 1024 + h * 64);
#pragma unroll
                for (int i = 0; i < 8; ++i) { const v4u u = vp[i]; o[8 * i + 0] += w * bflo(u.x); o[8 * i + 1] += w * bfhi(u.x); o[8 * i + 2] += w * bflo(u.y); o[8 * i + 3] += w * bfhi(u.y); o[8 * i + 4] += w * bflo(u.z); o[8 * i + 5] += w * bfhi(u.z); o[8 * i + 6] += w * bflo(u.w); o[8 * i + 7] += w * bfhi(u.w);
                    if ((i & 3) == 3) asm volatile("" ::: "memory"); }
            } else { const f32x4* vp = (const f32x4*)(MP + (size_t)(NMETA + s) * NPROJ + 1024 + h * 64);
#pragma unroll
                for (int i = 0; i < 16; ++i) { const f32x4 u = vp[i]; o[4 * i] += w * u.x; o[4 * i + 1] += w * u.y; o[4 * i + 2] += w * u.z; o[4 * i + 3] += w * u.w; if ((i & 3) == 3) asm volatile("" ::: "memory"); } }
            R += lk;
            if (R < -160.f) break;
        }
        float ss = 0.f;
#pragma unroll
        for (int d = 0; d < 64; ++d) ss += o[d] * o[d];
        const float rs = 1.0f / sqrtf(ss * (1.f / 64.f) + EPS);
        v4u* op = (v4u*)(MIX + row * D + h * 64);
#pragma unroll
        for (int i = 0; i < 8; ++i) { const float* g = F.sb_gain + h * 64 + 8 * i; v4u w; w.x = pk2(o[8 * i] * rs * g[0], o[8 * i + 1] * rs * g[1]); w.y = pk2(o[8 * i + 2] * rs * g[2], o[8 * i + 3] * rs * g[3]);
            w.z = pk2(o[8 * i + 4] * rs * g[4], o[8 * i + 5] * rs * g[5]); w.w = pk2(o[8 * i + 6] * rs * g[6], o[8 * i + 7] * rs * g[7]); op[i] = w; }
    }
}
__device__ __forceinline__ void p2_hgrn_naive(Frame& F) {
    const int grp = F.tid >> 7, dv = F.tid & 127;
    const bf16* HQ = (const bf16*)(F.ws + WS_HQ); const float* HG = (const float*)(F.ws + WS_HG); const bf16* HV = (const bf16*)(F.ws + WS_HV); const bf16* HGS = (const bf16*)(F.ws + WS_HGS);
    const float* MP = (const float*)(F.ws + WS_META); const float* LB = (const float*)(F.ws + WS_META + 256 * 1024); bf16* MIX = (bf16*)(F.ws + WS_MIXED);
    LAS float* red = (LAS float*)(F.lds);
    for (int pb = F.bx * 4; pb < NB * HGH; pb += F.G * 4) {
        const int p = pb + grp, b = p / HGH, h = p % HGH;
        float S[128];
#pragma unroll
        for (int i = 0; i < 128; ++i) S[i] = 0.f;
        for (int s = 0; s < NMETA; ++s) {
            const float v = MP[(size_t)s * NPROJ + 2560 + h * 128 + dv];
#pragma unroll
            for (int i = 0; i < 128; ++i) { const float fp = MP[(size_t)s * NPROJ + 2048 + h * 128 + i], lb = LB[h * 128 + i]; const float f = lb + (1.f - lb) / (1.f + __expf(-fp)); S[i] = f * S[i] + (1.f - f) * v; if ((i & 15) == 15) asm volatile("" ::: "memory"); }
        }
        for (int t = 0; t < SEQ; ++t) {
            const size_t row = (size_t)b * SEQ + t;
            const float v = bflo((unsigned)HV[row * 512 + h * 128 + dv]);
            float o = 0.f;
            const f32x4* gp = (const f32x4*)(HG + row * 512 + h * 128); const v2u* qp = (const v2u*)(HQ + row * 512 + h * 128);
#pragma unroll
            for (int i4 = 0; i4 < 32; ++i4) { const f32x4 g = gp[i4]; const v2u qq = qp[i4]; const float qv[4] = {bflo(qq.x), bfhi(qq.x), bflo(qq.y), bfhi(qq.y)};
#pragma unroll
                for (int j = 0; j < 4; ++j) { const float f = __expf(g[j]); S[4 * i4 + j] = f * S[4 * i4 + j] + (1.f - f) * v; o += qv[j] * S[4 * i4 + j]; }
                if ((i4 & 7) == 7) asm volatile("" ::: "memory"); }
            const float ss = wave_sum(o * o);
            if (F.lane == 0) red[F.wave] = ss;
            __syncthreads();
            const float tot = red[grp * 2] + red[grp * 2 + 1];
            __syncthreads();
            const float rs = 1.0f / sqrtf(tot * (1.f / 128.f) + EPS);
            MIX[row * D + 512 + h * 128 + dv] = (bf16)f2bf(o * rs * F.hg_gain[h * 128 + dv] * bflo((unsigned)HGS[row * 512 + h * 128 + dv]));
        }
    }
}

__device__ __forceinline__ void p4_router(Frame& F) {
    const bf16* HB = (const bf16*)(F.ws + WS_HB16); const bf16* WRT = (const bf16*)(F.ws + WS_WRT);
    unsigned* LT = (unsigned*)(F.ws + WS_LTOK); float* LGt = (float*)(F.ws + WS_LGATE); float* LRs = (float*)(F.ws + WS_LRSTD);
    LAS float* lg = (LAS float*)(F.lds) + F.wave * (16 * 48 + 16);
    volatile LAS int* M = (volatile LAS int*)F.MISC;
    const int fr = F.lane & 15, fq = F.lane >> 4;
    for (int tile = F.bx; tile < NTOK / 128; tile += F.G) {
        if (F.tid < NE) M[80 + F.tid] = 0;
        __syncthreads();
        const int row0 = tile * 128 + F.wave * 16;
        pg8::f32x4 acc[3]; acc[0] = acc[1] = acc[2] = (pg8::f32x4){0.f, 0.f, 0.f, 0.f}; float ss = 0.f;
        const bf16* ap = HB + (size_t)(row0 + fr) * D + 8 * fq; const bf16* bp = WRT + (size_t)fr * D + 8 * fq;
#pragma unroll 4
        for (int ks = 0; ks < 32; ++ks) {
            const bf16x8 a = *(const bf16x8*)(ap + 32 * ks);
            const v4u au = __builtin_bit_cast(v4u, a);
            ss += bflo(au.x) * bflo(au.x) + bfhi(au.x) * bfhi(au.x) + bflo(au.y) * bflo(au.y) + bfhi(au.y) * bfhi(au.y) + bflo(au.z) * bflo(au.z) + bfhi(au.z) * bfhi(au.z) + bflo(au.w) * bflo(au.w) + bfhi(au.w) * bfhi(au.w);
#pragma unroll
            for (int nt = 0; nt < 3; ++nt) { const bf16x8 bb = *(const bf16x8*)(bp + (size_t)nt * 16 * D + 32 * ks); acc[nt] = __builtin_amdgcn_mfma_f32_16x16x32_bf16(a, bb, acc[nt], 0, 0, 0); }
        }
        ss += __shfl_xor(ss, 16); ss += __shfl_xor(ss, 32);
#pragma unroll
        for (int nt = 0; nt < 3; ++nt)
#pragma unroll
            for (int j = 0; j < 4; ++j) lg[(fq * 4 + j) * 48 + nt * 16 + fr] = acc[nt][j];
        if (fq == 0) lg[16 * 48 + fr] = ss;
        __syncthreads();
        int e1 = 0, e2 = 0, r1 = 0, r2 = 0; float g1 = 0.f, g2 = 0.f, rstd = 0.f;
        if (F.lane < 16) {
            rstd = 1.0f / sqrtf(lg[16 * 48 + F.lane] * (1.f / D) + EPS);
            const LAS float* l = lg + F.lane * 48;
            float gl[4]; int gi = 0;
#pragma unroll
            for (int i = 0; i < 4; ++i) gl[i] = l[i] * rstd + F.b_rg[i];
#pragma unroll
            for (int i = 1; i < 4; ++i) if (gl[i] > gl[gi]) gi = i;
            float den = 0.f;
#pragma unroll
            for (int i = 0; i < 4; ++i) den += __expf(gl[i] - gl[gi]);
            const float pg = 1.0f / den;
            float v1 = -3.0e38f, v2 = -3.0e38f; int i1 = 0, i2 = 0;
            for (int i = 0; i < 8; ++i) { const float v = l[4 + gi * 8 + i] * rstd + F.b_re[gi * 8 + i]; if (v > v1) { v2 = v1; i2 = i1; v1 = v; i1 = i; } else if (v > v2) { v2 = v; i2 = i; } }
            const float ex = __expf(v2 - v1); g1 = pg / (1.f + ex); g2 = pg * ex / (1.f + ex);
            e1 = gi * 8 + i1; e2 = gi * 8 + i2;
            r1 = __hip_atomic_fetch_add((LAS int*)&M[80 + e1], 1, __ATOMIC_RELAXED, __HIP_MEMORY_SCOPE_WORKGROUP); r2 = __hip_atomic_fetch_add((LAS int*)&M[80 + e2], 1, __ATOMIC_RELAXED, __HIP_MEMORY_SCOPE_WORKGROUP);
        }
        __syncthreads();
        if (F.tid < NE) { const int n = M[80 + F.tid]; M[120 + F.tid] = n ? (int)__hip_atomic_fetch_add(F.ctl + CW_CNT + 64 * F.tid, (unsigned)n, RLX_AGENT) : 0; }
        __syncthreads();
        if (F.lane < 16) { const unsigned tok = (unsigned)(row0 + F.lane);
            const size_t p1 = (size_t)e1 * LCAP + M[120 + e1] + r1, p2 = (size_t)e2 * LCAP + M[120 + e2] + r2;
            LT[p1] = tok; LGt[p1] = g1; LRs[p1] = rstd; LT[p2] = tok | 0x40000000u; LGt[p2] = g2; LRs[p2] = rstd; }
        __syncthreads();
    }
}
__device__ __forceinline__ void p7_final(Frame& F) {
    const float* H = (const float*)(F.ws + WS_H); const bf16* Y0 = (const bf16*)(F.ws + WS_Y0); const bf16* Y1 = (const bf16*)(F.ws + WS_Y1);
    const int gw = F.bx * NWAVES + F.wave, NGW = F.G * NWAVES;
    f32x4 gf[4];
#pragma unroll
    for (int j = 0; j < 4; ++j) gf[j] = *(const f32x4*)(F.g_final + 4 * F.lane + 256 * j);
    for (int m = gw; m < NTOK; m += NGW) {
        const GAS f32x4* hr = (const GAS f32x4*)(H + (size_t)m * D) + F.lane; const GAS v2u* y0 = (const GAS v2u*)(Y0 + (size_t)m * D) + F.lane; const GAS v2u* y1 = (const GAS v2u*)(Y1 + (size_t)m * D) + F.lane;
        f32x4 v[4]; float s = 0.f;
#pragma unroll
        for (int j = 0; j < 4; ++j) { v[j] = hr[64 * j]; const v2u a = y0[64 * j], b = y1[64 * j];
            v[j].x += bflo(a.x) + bflo(b.x); v[j].y += bfhi(a.x) + bfhi(b.x); v[j].z += bflo(a.y) + bflo(b.y); v[j].w += bfhi(a.y) + bfhi(b.y);
            s += (v[j].x * v[j].x + v[j].y * v[j].y) + (v[j].z * v[j].z + v[j].w * v[j].w); }
        const float rstd = 1.0f / sqrtf(wave_sum(s) * (1.f / D) + EPS);
        GAS f32x4* o = (GAS f32x4*)(F.out + (size_t)m * D) + F.lane;
#pragma unroll
        for (int j = 0; j < 4; ++j) o[64 * j] = v[j] * rstd * gf[j];
    }
}

constexpr int NPHASES = 8;
__global__ void __launch_bounds__(NWAVES * 64, 2) hymba_fwd(Args args) {
    extern __shared__ __attribute__((aligned(16))) unsigned char lds[];
    Frame F;
    F.lds = (LAS unsigned char*)lds; F.MISC = (volatile LAS unsigned*)(F.lds + MISC_OFF);
    F.tid = threadIdx.x; F.lane = F.tid & 63; F.wave = __builtin_amdgcn_readfirstlane(F.tid >> 6); F.G = gridDim.x; F.bx = blockIdx.x;
    F.ws = args.ws; F.ctl = (gu32*)(args.ws + WS_CTL); F.out = args.out;
    F.x = args.in[0]; F.meta = args.in[1]; F.lb_logits = args.in[2]; F.g_mix = args.in[3]; F.w_in = args.in[4]; F.sb_gain = args.in[5]; F.hg_gain = args.in[6]; F.w_out = args.in[7]; F.g_ffn = args.in[8];
    F.w_rg = args.in[9]; F.b_rg = args.in[10]; F.w_re = args.in[11]; F.b_re = args.in[12]; F.w_gate = args.in[13]; F.w_up = args.in[14]; F.w_down = args.in[15]; F.g_final = args.in[16];
    for (int u = F.tid; u < 256; u += NWAVES * 64) F.MISC[u] = 0u;
    __syncthreads();
#if !MK_PER_PHASE
    XcdBarrier bar = xcd_barrier_post((unsigned*)(F.ctl + CW_BAR), F.MISC + 200);
#define GRID_BAR() xcd_barrier(bar)
#else
#define GRID_BAR() do {} while (0)
#endif
    const int lo = args.ph_lo, hi = args.ph_hi;
#define IN(k) (lo <= (k) && (k) < hi)
#define BOTH(k) (IN(k) && IN((k) + 1))
    unsigned char* ws = args.ws;

#ifndef SKIP_P0
    if (IN(0)) { p0_prologue(F); if (BOTH(0)) GRID_BAR(); }
#endif

#ifndef SKIP_P1
    if (IN(1)) {
        pg8::StaticOrder S; S.init(ws + WS_XB, ws + WS_WIN, NTOK, NPROJ, D, F.G, F.bx);
        EpiInProj E{(const float*)(ws + WS_RSTD1), (const float*)(ws + WS_META + 256 * 1024), (bf16*)(ws + WS_QKV), (bf16*)(ws + WS_HQ), (float*)(ws + WS_HG), (bf16*)(ws + WS_HV), (bf16*)(ws + WS_HGS)};
        pg8::gemm_phase<EpiInProj, pg8::StaticOrder>(F.lds + RING_OFF, D, S, E);
        if (BOTH(1)) GRID_BAR();
    }
#endif
#ifndef SKIP_P2
    if (IN(2)) {
#ifndef SKIP_P2A
 p2_attention_naive(F);
#endif
#ifndef SKIP_P2H
 p2_hgrn_naive(F);
#endif
 if (BOTH(2)) GRID_BAR(); }
#endif

#ifndef SKIP_P3
    if (IN(3)) {
        pg8::StaticOrder S; S.init(ws + WS_MIXED, ws + WS_WOUT, NTOK, D, D, F.G, F.bx);
        EpiOutProj E{F.x, (float*)(ws + WS_H), (bf16*)(ws + WS_HB16)};
        pg8::gemm_phase<EpiOutProj, pg8::StaticOrder>(F.lds + RING_OFF, D, S, E);
        if (BOTH(3)) GRID_BAR();
    }
#endif
#ifndef SKIP_P4
    if (IN(4)) { p4_router(F); if (BOTH(4)) GRID_BAR(); }
#endif

#ifndef SKIP_P5
    if (IN(5)) {
        const int nunits = moe_setup(F, 0);
        MoeOrder<true> S{(const LAS int*)F.MISC, (const LAS int*)F.MISC + 40, (const LAS unsigned*)(F.lds + LIST_OFF), (const char*)(ws + WS_HB16), (const char*)(ws + WS_WGU), D, F.G, F.bx, nunits};
        EpiGateUp E{(const LAS float*)(F.lds + LIST_OFF + 8192), (bf16*)(ws + WS_HBUF)};
        pg8::gemm_phase<EpiGateUp, MoeOrder<true>>(F.lds + RING_OFF, D, S, E);
        if (BOTH(5)) GRID_BAR();
    }
#endif
#ifndef SKIP_P6
    if (IN(6)) {
        const int nunits = moe_setup(F, 1);
        MoeOrder<false> S{(const LAS int*)F.MISC, (const LAS int*)F.MISC + 40, (const LAS unsigned*)(F.lds + LIST_OFF), (const char*)(ws + WS_HBUF), (const char*)(ws + WS_WDN), FF, F.G, F.bx, nunits};
        EpiDown E{(const LAS unsigned*)(F.lds + LIST_OFF), (const LAS float*)(F.lds + LIST_OFF + 8192), (bf16*)(ws + WS_Y0), (bf16*)(ws + WS_Y1)};
        pg8::gemm_phase<EpiDown, MoeOrder<false>>(F.lds + RING_OFF, FF, S, E);
        if (BOTH(6)) GRID_BAR();
    }
#endif
#ifndef SKIP_P7
    if (IN(7)) p7_final(F);
#endif
#undef IN
#undef BOTH
}

extern "C" void kernel_launch(void* const* d_in, const int* in_sizes, int n_in, void* d_out, int out_size, void* d_ws, size_t ws_size, hipStream_t stream) {
    static int grid = 0;
    if (grid == 0) {
        if (n_in != 17 || in_sizes[0] != NTOK * D || out_size != NTOK * D || ws_size < WS_END) { fprintf(stderr, "kernel_launch: unexpected shapes (n_in %d, in0 %d, out %d, ws %zu)\n", n_in, n_in > 0 ? in_sizes[0] : -1, out_size, ws_size); grid = -1; return; }
        int dev = 0, cus = 0, per_cu = 0;
        if (hipGetDevice(&dev) != hipSuccess || hipDeviceGetAttribute(&cus, hipDeviceAttributeMultiprocessorCount, dev) != hipSuccess) { grid = -1; return; }
        if (hipFuncSetAttribute((const void*)hymba_fwd, hipFuncAttributeMaxDynamicSharedMemorySize, LDS_BYTES) != hipSuccess) { fprintf(stderr, "kernel_launch: hipFuncSetAttribute failed\n"); grid = -1; return; }
        if (hipOccupancyMaxActiveBlocksPerMultiprocessor(&per_cu, (const void*)hymba_fwd, NWAVES * 64, LDS_BYTES) != hipSuccess || per_cu < 1) { fprintf(stderr, "kernel_launch: occupancy query says %d\n", per_cu); }
        (void)hipGetLastError();
        grid = cus;
    }
    if (grid < 0) return;
    hipMemsetAsync((char*)d_ws + WS_CTL, 0, CTL_ZERO_BYTES, stream);
    Args a{};
    for (int i = 0; i < 17; ++i) a.in[i] = (const float*)d_in[i];
    a.out = (float*)d_out; a.ws = (unsigned char*)d_ws;
#if MK_PER_PHASE
    for (int p = 0; p < NPHASES; ++p) { a.ph_lo = p; a.ph_hi = p + 1; hipLaunchKernelGGL(hymba_fwd, dim3(grid), dim3(NWAVES * 64), LDS_BYTES, stream, a); }
#else
    a.ph_lo = 0; a.ph_hi = NPHASES; hipLaunchKernelGGL(hymba_fwd, dim3(grid), dim3(NWAVES * 64), LDS_BYTES, stream, a);
#endif
}
```

```cpp
#include <hip/hip_runtime.h>
#include <cstdio>
#include <cstdint>

#define MK_PER_PHASE 0

namespace pg8 {
#define PG8_LAS __attribute__((address_space(3)))
typedef unsigned short bf16_t;
typedef short bf16x8 __attribute__((ext_vector_type(8)));
typedef float f32x4 __attribute__((ext_vector_type(4)));
typedef unsigned u32x4 __attribute__((ext_vector_type(4)));
constexpr int BM = 256, BK = 64, HALF = 128, HTB = HALF * BK * 2  , STAGE_BYTES = 8 * HTB, NXCD = 8, WGM = 8;

__host__ __device__ __forceinline__ int lds_byte(int r, int c) { const int st = (r >> 4) * 2 + (c >> 5), rr = r & 15, cc = c & 31, ob = rr * 64 + cc * 2; return st * 1024 + (ob ^ (((ob >> 9) & 1) << 5)); }
__host__ __device__ __forceinline__ void stage_rc(int b, int& R, int& C) { const int st = b / 1024, sb = b % 1024, swz = sb ^ (((sb >> 9) & 1) << 5); R = (st >> 1) * 16 + swz / 64; C = (st & 1) * 32 + (swz % 64) / 2; }
__host__ __device__ __forceinline__ int perm32(int rho) { const int n = rho >> 4, i = rho & 15; return 8 * (i >> 2) + 4 * n + (i & 3); }

struct Unit { int pm, pn, e, rows; };

struct StaticOrder {
    const char* A; const char* Bt; int K, nM, nN, nwg, G, c;
    __device__ void init(const void* A_, const void* Bt_, int M, int N, int K_, int G_, int c_) { A = (const char*)A_; Bt = (const char*)Bt_; K = K_; nM = M / BM; nN = N / BM; nwg = nM * nN; G = G_; c = c_; }
    __device__ bool next(int i, Unit& u) const {
        const long L = (long)i * G + c; if (L >= nwg) return false;
        int wgid = (int)L; { const int q = nwg / NXCD, r = nwg % NXCD, xcd = wgid % NXCD, off = wgid / NXCD; wgid = (xcd < r ? xcd * (q + 1) : r * (q + 1) + (xcd - r) * q) + off; }
        const int nig = WGM * nN, gid = wgid / nig, fm = gid * WGM, gsz = (nM - fm) < WGM ? (nM - fm) : WGM;
        u.pm = fm + ((wgid % nig) % gsz); u.pn = (wgid % nig) / gsz; u.e = 0; u.rows = BM; return true;
    }
    __device__ __forceinline__ const char* a_base(const Unit& u) const { return A + (size_t)u.pm * BM * K * 2; }
    __device__ __forceinline__ const char* b_base(const Unit& u) const { return Bt + (size_t)u.pn * BM * K * 2; }
    __device__ __forceinline__ void a_off(const Unit&, int, const int (&sR)[2], const int (&sC)[2], unsigned (&g)[2][2]) const {
#pragma unroll
        for (int h = 0; h < 2; ++h)
#pragma unroll
            for (int i = 0; i < 2; ++i) g[h][i] = (unsigned)((h * HALF + sR[i]) * K + sC[i]) * 2u;
    }
};

__device__ __forceinline__ unsigned cvt_pk_bf16(float lo, float hi) { unsigned r; asm volatile("v_cvt_pk_bf16_f32 %0, %1, %2" : "=v"(r) : "v"(lo), "v"(hi)); return r; }

template <class Epi, class Sched>
__device__ __forceinline__ void gemm_phase(PG8_LAS unsigned char* lds, const int K, const Sched& S, const Epi& E) {
    const int tid = threadIdx.x, wid = __builtin_amdgcn_readfirstlane(tid >> 6), lane = tid & 63, wr = wid >> 2, wc = wid & 3, fr = lane & 15, fq = lane >> 4;
    const int nt = K / BK;
    unsigned voffB[2]; int sR[2], sC[2];
#pragma unroll
    for (int i = 0; i < 2; ++i) { int R, C; stage_rc(tid * 16 + i * 8192, R, C); sR[i] = R; sC[i] = C; const int Rb = Epi::PERM ? ((R & ~31) + perm32(R & 31)) : R; voffB[i] = (unsigned)(Rb * K + C) * 2u; }
    const size_t kstep = (size_t)(BK * 2);
    const size_t hstep = (size_t)HALF * K * 2;
    const unsigned ldsw = (unsigned)wid * 1024u;
    const int aoff = lds_byte(wr * 64 + fr, fq * 8), boff = lds_byte(wc * 32 + fr, fq * 8);
#define PG8_SA(b, h) (((b) * 2 + (h)) * HTB)
#define PG8_SB(b, h) ((4 + (b) * 2 + (h)) * HTB)
#define PG8_STAGE(bufoff, gbase, voff) do { _Pragma("unroll") for (int _i = 0; _i < 2; ++_i) \
        __builtin_amdgcn_global_load_lds((const unsigned*)((const char*)(gbase) + (voff)[_i]), (PG8_LAS unsigned*)(lds + (bufoff) + ldsw + _i * 8192), 16, 0, 0); } while (0)
#define PG8_LDA(dst, b, h) do { _Pragma("unroll") for (int m = 0; m < 4; ++m) _Pragma("unroll") for (int k = 0; k < 2; ++k) dst[m][k] = *(const PG8_LAS bf16x8*)(lds + PG8_SA(b, h) + aoff + m * 2048 + k * 1024); } while (0)
#define PG8_LDB(dst, b, h) do { _Pragma("unroll") for (int n = 0; n < 2; ++n) _Pragma("unroll") for (int k = 0; k < 2; ++k) dst[n][k] = *(const PG8_LAS bf16x8*)(lds + PG8_SB(b, h) + boff + n * 2048 + k * 1024); } while (0)
#define PG8_MMA(ai, bj, At, Bt) do { __builtin_amdgcn_s_setprio(1); _Pragma("unroll") for (int m = 0; m < 4; ++m) _Pragma("unroll") for (int n = 0; n < 2; ++n) _Pragma("unroll") for (int k = 0; k < 2; ++k) \
        acc[ai][bj][m][n] = __builtin_amdgcn_mfma_f32_16x16x32_bf16(Bt[n][k], At[m][k], acc[ai][bj][m][n], 0, 0, 0); __builtin_amdgcn_s_setprio(0); } while (0)
#define PG8_WAIT_V(n) asm volatile("s_waitcnt vmcnt(" #n ")" ::: "memory")
#define PG8_WAIT_L(n) asm volatile("s_waitcnt lgkmcnt(" #n ")" ::: "memory")
#define PG8_BAR __builtin_amdgcn_s_barrier()
#define PG8_SCHED __builtin_amdgcn_sched_barrier(0)
    Unit cur, nxt; int ui = 0;
    if (!S.next(0, cur)) return;
    f32x4 acc[2][2][4][2];
#pragma unroll
    for (int a = 0; a < 2; ++a)
#pragma unroll
        for (int b = 0; b < 2; ++b)
#pragma unroll
            for (int m = 0; m < 4; ++m)
#pragma unroll
                for (int n = 0; n < 2; ++n) acc[a][b][m][n] = (f32x4){0.f, 0.f, 0.f, 0.f};
    bf16x8 At[4][2], B0[2][2], B1[2][2];
    unsigned gc[2][2], gn[2][2];
    S.a_off(cur, 0, sR, sC, gc);
#pragma unroll
    for (int h = 0; h < 2; ++h)
#pragma unroll
        for (int i = 0; i < 2; ++i) gn[h][i] = gc[h][i];
    const char* cA = S.a_base(cur); const char* cB = S.b_base(cur);
    PG8_STAGE(PG8_SB(0, 0), cB, voffB); PG8_STAGE(PG8_SA(0, 0), cA, gc[0]); PG8_STAGE(PG8_SB(0, 1), cB + hstep, voffB); PG8_STAGE(PG8_SA(0, 1), cA, gc[1]);
    if (wr == 1) PG8_BAR;
    PG8_WAIT_V(4); PG8_BAR;
    PG8_STAGE(PG8_SB(1, 0), cB + kstep, voffB); PG8_STAGE(PG8_SA(1, 0), cA + kstep, gc[0]); PG8_STAGE(PG8_SB(1, 1), cB + hstep + kstep, voffB);
    PG8_WAIT_V(6); PG8_BAR;
    for (;;) {
        const bool has_next = S.next(ui + 1, nxt);
        const char* nA = has_next ? S.a_base(nxt) : cA; const char* nB = has_next ? S.b_base(nxt) : cB;
        for (int t = 0; t < nt; t += 2) {
            const bool last = (t == nt - 2);
            const char* a1 = cA + (size_t)(t + 1) * kstep;
            const char* a2 = last ? nA : cA + (size_t)(t + 2) * kstep; const char* b2 = last ? nB : cB + (size_t)(t + 2) * kstep;
            const char* a3 = a2 + kstep; const char* b3 = b2 + kstep;
            if (last && has_next) S.a_off(nxt, ui + 1, sR, sC, gn);
            unsigned g2[2][2];
#pragma unroll
            for (int h = 0; h < 2; ++h)
#pragma unroll
                for (int i = 0; i < 2; ++i) g2[h][i] = last ? gn[h][i] : gc[h][i];
            PG8_LDB(B0, 0, 0); PG8_SCHED; PG8_LDA(At, 0, 0); PG8_STAGE(PG8_SA(1, 1), a1, gc[1]);
            PG8_WAIT_L(8); PG8_BAR; PG8_WAIT_L(0); PG8_MMA(0, 0, At, B0); PG8_BAR; PG8_SCHED;
            PG8_LDB(B1, 0, 1); PG8_STAGE(PG8_SB(0, 0), b2, voffB);
            PG8_BAR; PG8_WAIT_L(0); PG8_MMA(0, 1, At, B1); PG8_BAR;
            PG8_LDA(At, 0, 1); PG8_STAGE(PG8_SA(0, 0), a2, g2[0]);
            PG8_BAR; PG8_WAIT_L(0); PG8_MMA(1, 0, At, B0); PG8_BAR; PG8_SCHED;
            PG8_STAGE(PG8_SB(0, 1), b2 + hstep, voffB);
            PG8_WAIT_V(6); PG8_BAR; PG8_MMA(1, 1, At, B1); PG8_BAR;
            PG8_LDB(B0, 1, 0); PG8_SCHED; PG8_LDA(At, 1, 0); PG8_STAGE(PG8_SA(0, 1), a2, g2[1]);
            PG8_WAIT_L(8); PG8_BAR; PG8_WAIT_L(0); PG8_MMA(0, 0, At, B0); PG8_BAR; PG8_SCHED;
            PG8_LDB(B1, 1, 1); PG8_STAGE(PG8_SB(1, 0), b3, voffB);
            PG8_BAR; PG8_WAIT_L(0); PG8_MMA(0, 1, At, B1); PG8_BAR;
            PG8_LDA(At, 1, 1); PG8_STAGE(PG8_SA(1, 0), a3, g2[0]);
            PG8_BAR; PG8_WAIT_L(0); PG8_MMA(1, 0, At, B0); PG8_BAR; PG8_SCHED;
            PG8_STAGE(PG8_SB(1, 1), b3 + hstep, voffB);
            PG8_WAIT_V(6); PG8_BAR; PG8_MMA(1, 1, At, B1); PG8_BAR;
        }
        E(acc, cur, ui, wr, wc, fr, fq);
        if (!has_next) break;
#pragma unroll
        for (int a = 0; a < 2; ++a)
#pragma unroll
            for (int b = 0; b < 2; ++b)
#pragma unroll
                for (int m = 0; m < 4; ++m)
#pragma unroll
                    for (int n = 0; n < 2; ++n) acc[a][b][m][n] = (f32x4){0.f, 0.f, 0.f, 0.f};
        cur = nxt; cA = nA; cB = nB; ++ui;
#pragma unroll
        for (int h = 0; h < 2; ++h)
#pragma unroll
            for (int i = 0; i < 2; ++i) gc[h][i] = gn[h][i];
    }
    PG8_WAIT_V(0);
    if (wr == 0) PG8_BAR;
    PG8_BAR;
#undef PG8_SA
#undef PG8_SB
#undef PG8_STAGE
#undef PG8_LDA
#undef PG8_LDB
#undef PG8_MMA
#undef PG8_WAIT_V
#undef PG8_WAIT_L
#undef PG8_BAR
#undef PG8_SCHED
}
}

constexpr int NWAVES = 8;
constexpr int NB = 8, SEQ = 4096, D = 1024, NTOK = NB * SEQ, NPROJ = 3584, NMETA = 16;
constexpr int SBH = 8, SBD = 64, HGH = 4, HGD = 128;
constexpr int NE = 32, FF = 512, LCAP = NTOK;
constexpr float EPS = 1e-6f;
constexpr float QSCALE = 0.125f * 1.4426950408889634f;

constexpr size_t MiB = 1u << 20;
constexpr size_t WS_CTL = 0, CTL_ZERO_BYTES = 1 * MiB;
constexpr size_t WS_WIN = 1 * MiB, WS_WOUT = 8 * MiB, WS_WRT = 10 * MiB, WS_WGU = 11 * MiB, WS_WDN = 75 * MiB;
constexpr size_t WS_META = 107 * MiB;
constexpr size_t WS_RSTD1 = 108 * MiB;
constexpr size_t WS_LTOK = 109 * MiB, WS_LGATE = 113 * MiB, WS_LRSTD = 117 * MiB;
constexpr size_t WS_XB = 121 * MiB;
constexpr size_t WS_MIXED = WS_XB, WS_HBUF = WS_XB;
constexpr size_t WS_QK = 193 * MiB, WS_VT = 257 * MiB, WS_QT = 321 * MiB, WS_KT = 353 * MiB, WS_KH = 385 * MiB, WS_HGS = 417 * MiB, WS_SST = 449 * MiB;
constexpr size_t WS_EGL = 109 * MiB;
constexpr size_t META_LB = 256 * 1024, META_KM = 320 * 1024, META_VTM = 352 * 1024, META_MKH = 384 * 1024;
constexpr size_t META_DUMMY0 = 0;
constexpr size_t WS_H = 193 * MiB, WS_HB16 = 321 * MiB;
constexpr size_t WS_Y0 = 321 * MiB, WS_Y1 = 385 * MiB;
constexpr size_t WS_END = 481 * MiB;
constexpr int CW_TMO = 0, CW_CODE = 1, CW_BAR = 4096, CW_CNT = 8192;

constexpr int RING_OFF = 0, RING_BYTES = 131072;
constexpr int LIST_OFF = RING_BYTES, LIST_BYTES = 16384;
constexpr int MISC_OFF = LIST_OFF + LIST_BYTES;
constexpr int LDS_BYTES = MISC_OFF + 1024;
static_assert(LDS_BYTES <= 160 * 1024, "LDS");

#define GAS __attribute__((address_space(1)))
#define LAS __attribute__((address_space(3)))
typedef unsigned short bf16;
typedef unsigned v4u __attribute__((ext_vector_type(4)));
typedef unsigned v2u __attribute__((ext_vector_type(2)));
typedef float f32x4 __attribute__((ext_vector_type(4)));
typedef short bf16x8 __attribute__((ext_vector_type(8)));
typedef GAS unsigned gu32;
#define RLX_AGENT __ATOMIC_RELAXED, __HIP_MEMORY_SCOPE_AGENT
#define LDS_WAIT() asm volatile("s_waitcnt lgkmcnt(0)" ::: "memory")
__device__ __forceinline__ unsigned f2bf(float f) { unsigned u = __builtin_bit_cast(unsigned, f); return (u + 0x7fffu + ((u >> 16) & 1u)) >> 16; }
__device__ __forceinline__ unsigned pk2(float lo, float hi) { return f2bf(lo) | (f2bf(hi) << 16); }
__device__ __forceinline__ float bflo(unsigned u) { return __builtin_bit_cast(float, u << 16); }
__device__ __forceinline__ float bfhi(unsigned u) { return __builtin_bit_cast(float, u & 0xffff0000u); }
__device__ __forceinline__ float silu_f(float x) { return x * __builtin_amdgcn_rcpf(1.0f + __expf(-x)); }
__device__ __forceinline__ float wave_sum(float v) {
#pragma unroll
    for (int o = 1; o < 64; o <<= 1) v += __shfl_xor(v, o);
    return v;
}

#define XB_TMO      128
#define XB_XCNT(j)  (256  + 64 * (j))
#define XB_XSUB(j)  (1280 + 64 * (j))
#define XB_XGEN(j)  (2304 + 64 * (j))
#define XB_TOP      3328
#define XB_TOPGEN   3392
#define XCD_BAR_WORDS 3456
#define XB_SPIN_CAP (1u << 18)
__device__ __forceinline__ unsigned xb_ld(unsigned* p)              { return __hip_atomic_load(p, __ATOMIC_RELAXED, __HIP_MEMORY_SCOPE_AGENT); }
__device__ __forceinline__ unsigned xb_add(unsigned* p, unsigned v) { return __hip_atomic_fetch_add(p, v, __ATOMIC_RELAXED, __HIP_MEMORY_SCOPE_AGENT); }
__device__ __forceinline__ unsigned xb_xcc_id() { return (unsigned)__builtin_amdgcn_s_getreg((3 << 11) | 20) & 0xFu; }
#define XB_SPIN(cond, bar) do { unsigned _sp = 0; while (cond) { __builtin_amdgcn_s_sleep(1); \
    if ((++_sp & 255u) == 0u) { if (xb_ld(&(bar)[XB_TMO])) break; if (_sp > XB_SPIN_CAP) { atomicAdd(&(bar)[XB_TMO], 1u); break; } } } } while (0)
struct XcdBarrier { unsigned* bar; unsigned x; volatile LAS unsigned* st; };
__device__ __forceinline__ XcdBarrier xcd_barrier_post(unsigned* bar, volatile LAS unsigned* st) {
    XcdBarrier b; b.bar = bar; b.x = xb_xcc_id(); b.st = st;
    if (threadIdx.x == 0) (void)xb_add(&bar[XB_XCNT(b.x)], 1u);
    return b;
}
__device__ __forceinline__ void xcd_barrier_complete(unsigned* bar, unsigned x, unsigned& nloc, unsigned& nx) {
    const unsigned G = gridDim.x * gridDim.y * gridDim.z;
    unsigned sum, cnt, mine, sp = 0u;
    for (;;) {
        sum = 0u; cnt = 0u; mine = 0u;
#pragma unroll
        for (unsigned j = 0; j < 16; ++j) { const unsigned c = xb_ld(&bar[XB_XCNT(j)]); sum += c; cnt += (c > 0u) ? 1u : 0u; mine = (j == x) ? c : mine; }
        if (sum == G) break;
        __builtin_amdgcn_s_sleep(1);
        if ((++sp & 255u) == 0u) { if (xb_ld(&bar[XB_TMO])) break; if (sp > XB_SPIN_CAP) { atomicAdd(&bar[XB_TMO], 1u); break; } }
    }
    nloc = mine > 0u ? mine : 1u; nx = cnt > 0u ? cnt : 1u;
}
__device__ __forceinline__ void xcd_barrier(const XcdBarrier& b) {
    asm volatile("s_waitcnt vmcnt(0)" ::: "memory");
    __syncthreads();
    if (threadIdx.x == 0) {
        unsigned* bar = b.bar;
        __builtin_amdgcn_s_waitcnt(0);
        unsigned nloc = b.st[0], nx = b.st[1];
        if (nloc == 0u) { xcd_barrier_complete(bar, b.x, nloc, nx); b.st[0] = nloc; b.st[1] = nx; }
        const unsigned old = xb_add(&bar[XB_XSUB(b.x)], 1u);
        const unsigned gen = old / nloc;
        if (old + 1u == (gen + 1u) * nloc) {
            __builtin_amdgcn_fence(__ATOMIC_RELEASE, "agent");
            asm volatile("s_waitcnt vmcnt(0)" ::: "memory");
            const unsigned og = xb_add(&bar[XB_TOP], 1u);
            const unsigned tg = og / nx;
            if (og + 1u == (tg + 1u) * nx) xb_add(&bar[XB_TOPGEN], 1u);
            else XB_SPIN(xb_ld(&bar[XB_TOPGEN]) == tg, bar);
            __builtin_amdgcn_fence(__ATOMIC_ACQUIRE, "agent");
            xb_add(&bar[XB_XGEN(b.x)], 1u);
            asm volatile("s_waitcnt vmcnt(0)" ::: "memory");
        } else {
            XB_SPIN(xb_ld(&bar[XB_XGEN(b.x)]) == gen, bar);
            __builtin_amdgcn_fence(__ATOMIC_ACQUIRE, "agent");
            asm volatile("s_waitcnt vmcnt(0)" ::: "memory");
        }
    }
    __syncthreads();
}

struct Args { const float* in[17]; float* out; unsigned char* ws; int ph_lo, ph_hi; };
struct Frame {
    LAS unsigned char* lds; volatile LAS unsigned* MISC; gu32* ctl; unsigned char* ws;
    int tid, lane, wave, G, bx;
    const float *x, *meta, *lb_logits, *g_mix, *w_in, *sb_gain, *hg_gain, *w_out, *g_ffn, *w_rg, *b_rg, *w_re, *b_re, *w_gate, *w_up, *w_down, *g_final;
    float* out;
};

__device__ __forceinline__ void p0_transpose_item(const float* W, int ldw, int srcc0, int k0, bf16* WT, int Kd, int dstr0, const float* gain, LAS float* scr, int lane) {
#pragma unroll 8
    for (int i = 0; i < 32; ++i) { const int kk = 2 * i + (lane >> 5); float v = W[(size_t)(k0 + kk) * ldw + srcc0 + (lane & 31)]; if (gain) v *= gain[k0 + kk]; scr[kk * 33 + (lane & 31)] = v; }
    LDS_WAIT(); asm volatile("" ::: "memory");
    const int c = lane & 7;
#pragma unroll
    for (int j = 0; j < 4; ++j) { const int n = (lane >> 3) + 8 * j; const LAS float* s = scr + (8 * c) * 33 + n;
        v4u o; o.x = pk2(s[0 * 33], s[1 * 33]); o.y = pk2(s[2 * 33], s[3 * 33]); o.z = pk2(s[4 * 33], s[5 * 33]); o.w = pk2(s[6 * 33], s[7 * 33]);
        *(GAS v4u*)(WT + (size_t)(dstr0 + n) * Kd + k0 + 8 * c) = o; }
    LDS_WAIT(); asm volatile("" ::: "memory");
}
__device__ __forceinline__ void p0_prologue(Frame& F) {
    unsigned char* ws = F.ws;
    const int gw = F.bx * NWAVES + F.wave, NGW = F.G * NWAVES;
    {
        LAS float* am = (LAS float*)(F.lds);
        LAS float* red = (LAS float*)(F.lds + 65536);
        for (int r = F.wave * 2; r < F.wave * 2 + 2; ++r) {
            const GAS f32x4* xr = (const GAS f32x4*)(F.meta + (size_t)r * D) + F.lane; f32x4 v[4]; float s = 0.f;
#pragma unroll
            for (int j = 0; j < 4; ++j) { v[j] = xr[64 * j]; s += (v[j].x * v[j].x + v[j].y * v[j].y) + (v[j].z * v[j].z + v[j].w * v[j].w); }
            const float rstd = 1.0f / sqrtf(wave_sum(s) * (1.f / D) + EPS);
#pragma unroll
            for (int j = 0; j < 4; ++j) { const int k = 4 * F.lane + 256 * j; const f32x4 g = *(const GAS f32x4*)(F.g_mix + k);
                am[r * D + k + 0] = v[j].x * rstd * g.x; am[r * D + k + 1] = v[j].y * rstd * g.y; am[r * D + k + 2] = v[j].z * rstd * g.z; am[r * D + k + 3] = v[j].w * rstd * g.w; }
        }
        __syncthreads();
        for (int cb = F.bx; cb < NPROJ / 14; cb += F.G) {
            if (F.tid < 448) { const int c = F.tid % 14, ks = F.tid / 14, col = cb * 14 + c; float a[16];
#pragma unroll
                for (int r = 0; r < 16; ++r) a[r] = 0.f;
                for (int k = ks * 32; k < ks * 32 + 32; ++k) { const float w = F.w_in[(size_t)k * NPROJ + col];
#pragma unroll
                    for (int r = 0; r < 16; ++r) a[r] += am[r * D + k] * w; }
#pragma unroll
                for (int r = 0; r < 16; ++r) red[(ks * 14 + c) * 16 + r] = a[r]; }
            __syncthreads();
            if (F.tid < 224) { const int c = F.tid / 16, r = F.tid % 16; float s = 0.f;
                for (int ks = 0; ks < 32; ++ks) s += red[(ks * 14 + c) * 16 + r];
                red[c * 16 + r] = s;
                const int col = cb * 14 + c; ((float*)(ws + WS_META))[r * NPROJ + col] = s;
                if (col >= 512 && col < 1024) { bf16* KM = (bf16*)(ws + WS_META + META_KM); KM[r * 512 + col - 512] = (bf16)f2bf(s); KM[(16 + r) * 512 + col - 512] = 0; }
                if (col >= 1024 && col < 1536) { bf16* VTM = (bf16*)(ws + WS_META + META_VTM); VTM[(col - 1024) * 32 + r] = (bf16)f2bf(s); VTM[(col - 1024) * 32 + 16 + r] = 0; } }
            __syncthreads();
            if (F.tid < 14) { const int col = cb * 14 + F.tid;
                if (col >= 2048 && col < 2560) { const int d = col - 2048; const float la = F.lb_logits[d], lb2 = F.lb_logits[512 + d], mx = fmaxf(la, lb2), ea = __expf(la - mx), eb = __expf(lb2 - mx), lb = ea / (ea + eb);
                    float Gs[16], ks[16], G = 0.f;
#pragma unroll
                    for (int r = 0; r < 16; ++r) { const float xx = red[F.tid * 16 + r], sg = 1.0f / (1.0f + __expf(-xx)), f = lb + (1.f - lb) * sg; G += __logf(f); Gs[r] = G; ks[r] = (1.f - lb) * (1.f - sg); }
#pragma unroll
                    for (int r = 0; r < 16; ++r) ((float*)(ws + WS_META + META_MKH))[r * 512 + d] = ks[r] * __expf(G - Gs[r]); } }
            __syncthreads();
        }
    }
    if (F.bx == (1 % F.G)) { float* LB = (float*)(ws + WS_META + META_LB); const float a = F.lb_logits[F.tid], b = F.lb_logits[512 + F.tid], m = fmaxf(a, b), ea = __expf(a - m), eb = __expf(b - m); LB[F.tid] = ea / (ea + eb); }
    for (int i = F.bx * 512 + F.tid; i < 48 * D; i += F.G * 512) { const int e = i / D, k = i % D; float v = 0.f; if (e < 4) v = F.w_rg[k * 4 + e]; else if (e < 36) v = F.w_re[k * 32 + (e - 4)]; ((bf16*)(ws + WS_WRT))[i] = (bf16)f2bf(v * F.g_ffn[k]); }
    {
        LAS float* scr = (LAS float*)(F.lds + RING_OFF + F.wave * 16384);
        constexpr int I_IN = (D / 64) * (NPROJ / 32), I_OUT = (D / 64) * (D / 32), I_GU = NE * (D / 64) * (1024 / 32), I_DN = NE * (FF / 64) * (D / 32);
        constexpr int NITEMS = I_IN + I_OUT + I_GU + I_DN;
        for (int it = gw; it < NITEMS; it += NGW) {
            int r = it;
            if (r < I_IN) { const int nb = r % (NPROJ / 32), kb = r / (NPROJ / 32), r0 = 32 * nb; int src;
                if (r0 < 1024) src = r0; else if (r0 < 2048) { const int q = r0 - 1024, blk = q / 256, wi = q % 256; src = (wi >= 128 ? 2048 : 1536) + 128 * blk + (wi % 128); }
                else if (r0 < 2560) src = 3072 + (r0 - 2048); else if (r0 < 3072) src = 1024 + (r0 - 2560); else src = 2560 + (r0 - 3072);
                p0_transpose_item(F.w_in, NPROJ, src, 64 * kb, (bf16*)(ws + WS_WIN), D, 32 * nb, F.g_mix, scr, F.lane); continue; } r -= I_IN;
            if (r < I_OUT) { const int nb = r % (D / 32), kb = r / (D / 32); p0_transpose_item(F.w_out, D, 32 * nb, 64 * kb, (bf16*)(ws + WS_WOUT), D, 32 * nb, nullptr, scr, F.lane); continue; } r -= I_OUT;
            if (r < I_GU) { const int e = r / (16 * 32), q = r % (16 * 32), nb = q % 32, kb = q / 32, pn = nb / 8, half = (nb % 8) / 4, i0 = (nb % 4) * 32;
                const float* src = (half ? F.w_up : F.w_gate) + (size_t)e * D * FF;
                p0_transpose_item(src, FF, 128 * pn + i0, 64 * kb, (bf16*)(ws + WS_WGU) + (size_t)e * 1024 * D, D, 32 * nb, F.g_ffn, scr, F.lane); continue; } r -= I_GU;
            { const int e = r / (8 * 32), q = r % (8 * 32), nb = q % 32, kb = q / 32;
                p0_transpose_item(F.w_down + (size_t)e * FF * D, D, 32 * nb, 64 * kb, (bf16*)(ws + WS_WDN) + (size_t)e * D * FF, FF, 32 * nb, nullptr, scr, F.lane); }
        }
    }
    for (int m = gw; m < NTOK; m += NGW) {
        const GAS f32x4* xr = (const GAS f32x4*)(F.x + (size_t)m * D) + F.lane; f32x4 v[4]; float s = 0.f;
#pragma unroll
        for (int j = 0; j < 4; ++j) { v[j] = xr[64 * j]; s += (v[j].x * v[j].x + v[j].y * v[j].y) + (v[j].z * v[j].z + v[j].w * v[j].w); }
        s = wave_sum(s);
        if (F.lane == 0) ((float*)(ws + WS_RSTD1))[m] = 1.0f / sqrtf(s * (1.f / D) + EPS);
        GAS v2u* o8 = (GAS v2u*)((bf16*)(ws + WS_XB) + (size_t)m * D) + F.lane;
#pragma unroll
        for (int j = 0; j < 4; ++j) { v2u w; w.x = pk2(v[j].x, v[j].y); w.y = pk2(v[j].z, v[j].w); o8[64 * j] = w; }
    }
}

struct EpiInProj {
    static constexpr bool PERM = true;
    const float* rstd; const float* LB; bf16* QK; bf16* QT; bf16* KT; bf16* KH; float* EGL; bf16* HGS;
    __device__ __forceinline__ void operator()(const pg8::f32x4 (&acc)[2][2][4][2], const pg8::Unit& u, int, int wr, int wc, int fr, int fq) const {
        const int row0 = u.pm * 256 + wr * 64 + fr, cl = wc * 32 + 8 * fq;
        if (u.pn >= 4 && u.pn < 8) {
            const int c0 = (u.pn - 4) * 128 + cl;
            const f32x4 lb0 = *(const f32x4*)(LB + c0), lb1 = *(const f32x4*)(LB + c0 + 4);
#pragma unroll
            for (int ai = 0; ai < 2; ++ai)
#pragma unroll
                for (int mp = 0; mp < 2; ++mp) {
                    const int rA = row0 + ai * 128 + mp * 32, rB = rA + 16; const float rsA = rstd[rA], rsB = rstd[rB];
                    float qt[2][8], kt[2][8], kh[2][8], egl[8];
#pragma unroll
                    for (int cc = 0; cc < 8; ++cc) {
                        const float lb = cc < 4 ? lb0[cc & 3] : lb1[cc & 3];
                        const float xq0 = acc[ai][0][2 * mp][cc >> 2][cc & 3] * rsA, xq1 = acc[ai][0][2 * mp + 1][cc >> 2][cc & 3] * rsB;
                        const float xf0 = acc[ai][1][2 * mp][cc >> 2][cc & 3] * rsA, xf1 = acc[ai][1][2 * mp + 1][cc >> 2][cc & 3] * rsB;
                        const float sg0 = __builtin_amdgcn_rcpf(1.f + __expf(-xf0)), sg1 = __builtin_amdgcn_rcpf(1.f + __expf(-xf1));
                        const float k0 = (1.f - lb) * (1.f - sg0), k1 = (1.f - lb) * (1.f - sg1);
                        float s0 = __logf(lb + (1.f - lb) * sg0), s1 = __logf(lb + (1.f - lb) * sg1);
#pragma unroll
                        for (int dd = 1; dd < 16; dd <<= 1) { const float y0 = __shfl_up(s0, dd, 16), y1 = __shfl_up(s1, dd, 16); if (fr >= dd) { s0 += y0; s1 += y1; } }
                        s1 += __shfl(s0, 15, 16);
                        const float GL = __shfl(s1, 15, 16);
                        qt[0][cc] = silu_f(xq0) * __expf(s0); qt[1][cc] = silu_f(xq1) * __expf(s1);
                        kt[0][cc] = k0 * __expf(-s0); kt[1][cc] = k1 * __expf(-s1);
                        kh[0][cc] = k0 * __expf(GL - s0); kh[1][cc] = k1 * __expf(GL - s1);
                        egl[cc] = __expf(GL);
                    }
#pragma unroll
                    for (int par = 0; par < 2; ++par) { const size_t off = (size_t)(par ? rB : rA) * 512 + c0; pg8::u32x4 w;
                        w.x = pg8::cvt_pk_bf16(qt[par][0], qt[par][1]); w.y = pg8::cvt_pk_bf16(qt[par][2], qt[par][3]); w.z = pg8::cvt_pk_bf16(qt[par][4], qt[par][5]); w.w = pg8::cvt_pk_bf16(qt[par][6], qt[par][7]); *(pg8::u32x4*)(QT + off) = w;
                        w.x = pg8::cvt_pk_bf16(kt[par][0], kt[par][1]); w.y = pg8::cvt_pk_bf16(kt[par][2], kt[par][3]); w.z = pg8::cvt_pk_bf16(kt[par][4], kt[par][5]); w.w = pg8::cvt_pk_bf16(kt[par][6], kt[par][7]); *(pg8::u32x4*)(KT + off) = w;
                        w.x = pg8::cvt_pk_bf16(kh[par][0], kh[par][1]); w.y = pg8::cvt_pk_bf16(kh[par][2], kh[par][3]); w.z = pg8::cvt_pk_bf16(kh[par][4], kh[par][5]); w.w = pg8::cvt_pk_bf16(kh[par][6], kh[par][7]); *(pg8::u32x4*)(KH + off) = w; }
                    if (fr == 15) { float* ep = EGL + (size_t)(rA >> 5) * 512 + c0; *(f32x4*)ep = (f32x4){egl[0], egl[1], egl[2], egl[3]}; *(f32x4*)(ep + 4) = (f32x4){egl[4], egl[5], egl[6], egl[7]}; }
                }
            return;
        }
        const int kind = u.pn < 2 ? 0 : (u.pn < 4 ? 1 : 2);
        bf16* dst = u.pn < 4 ? QK : HGS; const int ldc = u.pn < 4 ? 1024 : 512, c0 = (u.pn < 4 ? u.pn : u.pn - 8) * 256;
#pragma unroll
        for (int ai = 0; ai < 2; ++ai)
#pragma unroll
            for (int m = 0; m < 4; ++m) {
                const int row = row0 + ai * 128 + m * 16; const float rs = rstd[row];
#pragma unroll
                for (int bj = 0; bj < 2; ++bj) {
                    f32x4 v0 = acc[ai][bj][m][0] * rs, v1 = acc[ai][bj][m][1] * rs;
                    if (kind == 0) { v0 = v0 * QSCALE; v1 = v1 * QSCALE; }
                    if (kind == 2) {
#pragma unroll
                        for (int j = 0; j < 4; ++j) { v0[j] = silu_f(v0[j]); v1[j] = silu_f(v1[j]); } }
                    pg8::u32x4 w; w.x = pg8::cvt_pk_bf16(v0[0], v0[1]); w.y = pg8::cvt_pk_bf16(v0[2], v0[3]); w.z = pg8::cvt_pk_bf16(v1[0], v1[1]); w.w = pg8::cvt_pk_bf16(v1[2], v1[3]);
                    *(pg8::u32x4*)(dst + (size_t)row * ldc + c0 + bj * 128 + cl) = w;
                }
            }
    }
};
struct EpiVT {
    static constexpr bool PERM = true;
    const float* rstd; bf16* VT;
    __device__ __forceinline__ void operator()(const pg8::f32x4 (&acc)[2][2][4][2], const pg8::Unit& u, int, int wr, int wc, int fr, int fq) const {
        const int row0 = u.pm * 256 + wr * 64 + fr, col0 = u.pn * 256 + wc * 32 + 8 * fq;
        f32x4 rsv[2][2];
#pragma unroll
        for (int bj = 0; bj < 2; ++bj)
#pragma unroll
            for (int n = 0; n < 2; ++n) rsv[bj][n] = *(const f32x4*)(rstd + col0 + bj * 128 + 4 * n);
#pragma unroll
        for (int ai = 0; ai < 2; ++ai)
#pragma unroll
            for (int m = 0; m < 4; ++m) {
                bf16* rowp = VT + (size_t)(row0 + ai * 128 + m * 16) * NTOK + col0;
#pragma unroll
                for (int bj = 0; bj < 2; ++bj) { const f32x4 v0 = acc[ai][bj][m][0] * rsv[bj][0], v1 = acc[ai][bj][m][1] * rsv[bj][1];
                    pg8::u32x4 w; w.x = pg8::cvt_pk_bf16(v0[0], v0[1]); w.y = pg8::cvt_pk_bf16(v0[2], v0[3]); w.z = pg8::cvt_pk_bf16(v1[0], v1[1]); w.w = pg8::cvt_pk_bf16(v1[2], v1[3]);
                    *(pg8::u32x4*)(rowp + bj * 128) = w; }
            }
    }
};
struct EpiOutProj {
    static constexpr bool PERM = true;
    const float* x; float* H; bf16* HB16;
    __device__ __forceinline__ void operator()(const pg8::f32x4 (&acc)[2][2][4][2], const pg8::Unit& u, int, int wr, int wc, int fr, int fq) const {
        const int row0 = u.pm * 256 + wr * 64 + fr, col0 = u.pn * 256 + wc * 32 + 8 * fq;
#pragma unroll
        for (int ai = 0; ai < 2; ++ai)
#pragma unroll
            for (int m = 0; m < 4; ++m) {
                const size_t ro = (size_t)(row0 + ai * 128 + m * 16) * D + col0;
#pragma unroll
                for (int bj = 0; bj < 2; ++bj) {
                    const size_t off = ro + bj * 128;
                    const f32x4 v0 = acc[ai][bj][m][0] + *(const f32x4*)(x + off), v1 = acc[ai][bj][m][1] + *(const f32x4*)(x + off + 4);
                    *(f32x4*)(H + off) = v0; *(f32x4*)(H + off + 4) = v1;
                    pg8::u32x4 w; w.x = pg8::cvt_pk_bf16(v0[0], v0[1]); w.y = pg8::cvt_pk_bf16(v0[2], v0[3]); w.z = pg8::cvt_pk_bf16(v1[0], v1[1]); w.w = pg8::cvt_pk_bf16(v1[2], v1[3]);
                    *(pg8::u32x4*)(HB16 + off) = w;
                }
            }
    }
};
struct EpiGateUp {
    static constexpr bool PERM = true;
    const LAS float* lrstd; bf16* HBUF;
    __device__ __forceinline__ void operator()(const pg8::f32x4 (&acc)[2][2][4][2], const pg8::Unit& u, int ord, int wr, int wc, int fr, int fq) const {
        const int rl0 = wr * 64 + fr, col0 = u.pn * 128 + wc * 32 + 8 * fq;
#pragma unroll
        for (int ai = 0; ai < 2; ++ai)
#pragma unroll
            for (int m = 0; m < 4; ++m) {
                const int rl = rl0 + ai * 128 + m * 16; const float rs = lrstd[ord * 256 + rl];
                const f32x4 g0 = acc[ai][0][m][0] * rs, g1 = acc[ai][0][m][1] * rs, u0 = acc[ai][1][m][0] * rs, u1 = acc[ai][1][m][1] * rs;
                float h[8];
#pragma unroll
                for (int j = 0; j < 4; ++j) { h[j] = silu_f(g0[j]) * u0[j]; h[4 + j] = silu_f(g1[j]) * u1[j]; }
                pg8::u32x4 w; w.x = pg8::cvt_pk_bf16(h[0], h[1]); w.y = pg8::cvt_pk_bf16(h[2], h[3]); w.z = pg8::cvt_pk_bf16(h[4], h[5]); w.w = pg8::cvt_pk_bf16(h[6], h[7]);
                *(pg8::u32x4*)(HBUF + (size_t)(u.pm * 256 + rl) * FF + col0) = w;
            }
    }
};
struct EpiDown {
    static constexpr bool PERM = true;
    const LAS unsigned* ltok; const LAS float* lgate; bf16* Y0; bf16* Y1;
    __device__ __forceinline__ void operator()(const pg8::f32x4 (&acc)[2][2][4][2], const pg8::Unit& u, int ord, int wr, int wc, int fr, int fq) const {
        const int rl0 = wr * 64 + fr, col0 = u.pn * 256 + wc * 32 + 8 * fq;
#pragma unroll
        for (int ai = 0; ai < 2; ++ai)
#pragma unroll
            for (int m = 0; m < 4; ++m) {
                const int rl = rl0 + ai * 128 + m * 16; const unsigned tp = ltok[ord * 256 + rl]; const float gt = lgate[ord * 256 + rl];
                if (!(tp & 0x80000000u)) {
                    bf16* yb = ((tp >> 30) & 1u) ? Y1 : Y0; const size_t ro = (size_t)(tp & 0xffffu) * D + col0;
#pragma unroll
                    for (int bj = 0; bj < 2; ++bj) { const f32x4 v0 = acc[ai][bj][m][0] * gt, v1 = acc[ai][bj][m][1] * gt;
                        pg8::u32x4 w; w.x = pg8::cvt_pk_bf16(v0[0], v0[1]); w.y = pg8::cvt_pk_bf16(v0[2], v0[3]); w.z = pg8::cvt_pk_bf16(v1[0], v1[1]); w.w = pg8::cvt_pk_bf16(v1[2], v1[3]);
                        *(pg8::u32x4*)(yb + ro + bj * 128) = w; }
                }
            }
    }
};
template <bool GATHER> struct MoeOrder {
    const LAS int* tstart; const LAS int* cntl; const LAS unsigned* ltok; const char* A; const char* Bt; int K, G, c, nunits;
    __device__ bool next(int i, pg8::Unit& u) const {
        const int L = i * G + c; if (L >= nunits) return false;
        const int rt = L >> 2; int e = 0;
        while (e < NE - 1 && tstart[e + 1] <= rt) ++e;
        e = __builtin_amdgcn_readfirstlane(e);
        u.pm = rt; u.pn = L & 3; u.e = e; const int left = cntl[e] - (rt - tstart[e]) * 256; u.rows = __builtin_amdgcn_readfirstlane(left < 256 ? left : 256); return true;
    }
    __device__ __forceinline__ const char* a_base(const pg8::Unit& u) const { return GATHER ? A : A + (size_t)u.pm * 256 * K * 2; }
    __device__ __forceinline__ const char* b_base(const pg8::Unit& u) const { return Bt + ((size_t)u.e * 1024 + (size_t)u.pn * 256) * K * 2; }
    __device__ __forceinline__ void a_off(const pg8::Unit&, int ord, const int (&sR)[2], const int (&sC)[2], unsigned (&g)[2][2]) const {
#pragma unroll
        for (int h = 0; h < 2; ++h)
#pragma unroll
            for (int i = 0; i < 2; ++i) {
                if (GATHER) g[h][i] = ((ltok[ord * 256 + h * 128 + sR[i]] & 0xffffu) * (unsigned)K + (unsigned)sC[i]) * 2u;
                else g[h][i] = (unsigned)((h * 128 + sR[i]) * K + sC[i]) * 2u;
            }
    }
};
__device__ __forceinline__ int moe_setup(Frame& F, int which  ) {
    volatile LAS int* M = (volatile LAS int*)F.MISC;
    if (F.tid < NE) M[40 + F.tid] = (int)__hip_atomic_load(F.ctl + CW_CNT + 64 * F.tid, RLX_AGENT);
    __syncthreads();
    if (F.tid == 0) { int s = 0; for (int e = 0; e < NE; ++e) { M[e] = s; s += (M[40 + e] + 255) >> 8; } M[NE] = s; }
    __syncthreads();
    const int nrt = M[NE], nunits = nrt * 4;
    LAS unsigned* ltok = (LAS unsigned*)(F.lds + LIST_OFF); LAS float* lval = (LAS float*)(F.lds + LIST_OFF + 8192);
    const unsigned* LT = (const unsigned*)(F.ws + WS_LTOK); const float* LV = (const float*)(F.ws + (which ? WS_LGATE : WS_LRSTD));
    for (int i = 0; i < 8; ++i) {
        const int L = i * F.G + F.bx; if (L >= nunits) break;
        const int rt = L >> 2; int e = 0; while (e < NE - 1 && M[e + 1] <= rt) ++e;
        if (F.tid < 256) { const int idx = (rt - M[e]) * 256 + F.tid; const bool ok = idx < M[40 + e];
            ltok[i * 256 + F.tid] = ok ? LT[(size_t)e * LCAP + idx] : 0x80000000u; lval[i * 256 + F.tid] = ok ? LV[(size_t)e * LCAP + idx] : 0.f; }
    }
    __syncthreads();
    return nunits;
}

typedef float f32x16 __attribute__((ext_vector_type(16)));
__device__ __forceinline__ void p2_attention(Frame& F) {
    const bf16* QK = (const bf16*)(F.ws + WS_QK); const bf16* VT = (const bf16*)(F.ws + WS_VT);
    const bf16* KM = (const bf16*)(F.ws + WS_META + META_KM); const bf16* VTM = (const bf16*)(F.ws + WS_META + META_VTM); bf16* MIX = (bf16*)(F.ws + WS_MIXED);
    const int c = F.lane & 31, hh = F.lane >> 5;
    const int gw = F.bx * NWAVES + F.wave, NGW = F.G * NWAVES;
    for (int item = gw; item < NB * SBH * (SEQ / 32); item += NGW) {
        const int qb = item & 127, h = (item >> 7) & 7, b = item >> 10;
        const size_t tok0 = (size_t)b * SEQ;
        bf16x8 qf[4];
        { const bf16* qp = QK + (tok0 + 32 * qb + c) * 1024 + h * 64 + 8 * hh;
#pragma unroll
            for (int ks = 0; ks < 4; ++ks) qf[ks] = *(const bf16x8*)(qp + 16 * ks); }
        f32x16 o0, o1;
#pragma unroll
        for (int i = 0; i < 16; ++i) { o0[i] = 0.f; o1[i] = 0.f; }
        float R = 0.f;
        for (int kt = qb; kt >= -1; --kt) {
            const bf16* kp = kt >= 0 ? QK + (tok0 + 32 * kt + c) * 1024 + 512 + h * 64 + 8 * hh : KM + c * 512 + h * 64 + 8 * hh;
            const bf16* vp = kt >= 0 ? VT + (size_t)(h * 64 + c) * NTOK + tok0 + 32 * kt + 4 * hh : VTM + (h * 64 + c) * 32 + 4 * hh;
            const size_t vblk = kt >= 0 ? (size_t)32 * NTOK : (size_t)32 * 32;
            bf16x8 kf[4];
#pragma unroll
            for (int ks = 0; ks < 4; ++ks) kf[ks] = *(const bf16x8*)(kp + 16 * ks);
            v2u vlo[2][2], vhi[2][2];
#pragma unroll
            for (int bl = 0; bl < 2; ++bl)
#pragma unroll
                for (int sx = 0; sx < 2; ++sx) { vlo[bl][sx] = *(const v2u*)(vp + bl * vblk + 16 * sx); vhi[bl][sx] = *(const v2u*)(vp + bl * vblk + 16 * sx + 8); }
            f32x16 st;
#pragma unroll
            for (int i = 0; i < 16; ++i) st[i] = 0.f;
#pragma unroll
            for (int ks = 0; ks < 4; ++ks) st = __builtin_amdgcn_mfma_f32_32x32x16_bf16(kf[ks], qf[ks], st, 0, 0, 0);
            const bool diag = (kt == qb), meta = (kt < 0);
            float lk[16], lbt[16]; bool ok[16];
#pragma unroll
            for (int r = 0; r < 16; ++r) { const int kk = (r & 3) + 8 * (r >> 2) + 4 * hh; const float z = st[r];
                const float L = __builtin_amdgcn_logf(1.0f + __builtin_amdgcn_exp2f(-fabsf(z)));
                ok[r] = diag ? (kk < c) : (meta ? (kk < NMETA) : true);
                lk[r] = ok[r] ? -(fmaxf(z, 0.f) + L) : 0.f; lbt[r] = fminf(z, 0.f) - L; }
            float sg[4], pp[4], tot[4];
#pragma unroll
            for (int g = 0; g < 4; ++g) { sg[g] = (lk[4 * g] + lk[4 * g + 1]) + (lk[4 * g + 2] + lk[4 * g + 3]); pp[g] = __shfl_xor(sg[g], 32); tot[g] = sg[g] + pp[g]; }
            float lat[4]; lat[3] = 0.f; lat[2] = tot[3]; lat[1] = tot[3] + tot[2]; lat[0] = lat[1] + tot[1];
            float w[16];
#pragma unroll
            for (int g = 0; g < 4; ++g) { const float base = R + lat[g] + (hh == 0 ? pp[g] : 0.f);
                const float t3 = base, t2 = t3 + lk[4 * g + 3], t1 = t2 + lk[4 * g + 2], t0 = t1 + lk[4 * g + 1];
                w[4 * g + 3] = ok[4 * g + 3] ? __builtin_amdgcn_exp2f(lbt[4 * g + 3] + t3) : 0.f; w[4 * g + 2] = ok[4 * g + 2] ? __builtin_amdgcn_exp2f(lbt[4 * g + 2] + t2) : 0.f;
                w[4 * g + 1] = ok[4 * g + 1] ? __builtin_amdgcn_exp2f(lbt[4 * g + 1] + t1) : 0.f; w[4 * g + 0] = ok[4 * g + 0] ? __builtin_amdgcn_exp2f(lbt[4 * g + 0] + t0) : 0.f; }
            R += lat[0] + tot[0];
#pragma unroll
            for (int sx = 0; sx < 2; ++sx) {
                v4u wu; wu.x = pg8::cvt_pk_bf16(w[8 * sx + 0], w[8 * sx + 1]); wu.y = pg8::cvt_pk_bf16(w[8 * sx + 2], w[8 * sx + 3]); wu.z = pg8::cvt_pk_bf16(w[8 * sx + 4], w[8 * sx + 5]); wu.w = pg8::cvt_pk_bf16(w[8 * sx + 6], w[8 * sx + 7]);
                const bf16x8 wf = __builtin_bit_cast(bf16x8, wu);
                v4u a0; a0.x = vlo[0][sx].x; a0.y = vlo[0][sx].y; a0.z = vhi[0][sx].x; a0.w = vhi[0][sx].y;
                v4u a1; a1.x = vlo[1][sx].x; a1.y = vlo[1][sx].y; a1.z = vhi[1][sx].x; a1.w = vhi[1][sx].y;
                o0 = __builtin_amdgcn_mfma_f32_32x32x16_bf16(__builtin_bit_cast(bf16x8, a0), wf, o0, 0, 0, 0);
                o1 = __builtin_amdgcn_mfma_f32_32x32x16_bf16(__builtin_bit_cast(bf16x8, a1), wf, o1, 0, 0, 0);
            }
            if (__all(R < -160.f)) break;
        }
        float ss = 0.f;
#pragma unroll
        for (int i = 0; i < 16; ++i) ss += o0[i] * o0[i] + o1[i] * o1[i];
        ss += __shfl_xor(ss, 32);
        const float rs = 1.0f / sqrtf(ss * (1.f / 64.f) + EPS);
        bf16* op = MIX + (tok0 + 32 * qb + c) * D + h * 64 + 4 * hh;
#pragma unroll
        for (int g = 0; g < 4; ++g) {
            const f32x4 g0 = *(const f32x4*)(F.sb_gain + h * 64 + 8 * g + 4 * hh), g1 = *(const f32x4*)(F.sb_gain + h * 64 + 32 + 8 * g + 4 * hh);
            v2u w0, w1; w0.x = pg8::cvt_pk_bf16(o0[4 * g] * rs * g0.x, o0[4 * g + 1] * rs * g0.y); w0.y = pg8::cvt_pk_bf16(o0[4 * g + 2] * rs * g0.z, o0[4 * g + 3] * rs * g0.w);
            w1.x = pg8::cvt_pk_bf16(o1[4 * g] * rs * g1.x, o1[4 * g + 1] * rs * g1.y); w1.y = pg8::cvt_pk_bf16(o1[4 * g + 2] * rs * g1.z, o1[4 * g + 3] * rs * g1.w);
            *(v2u*)(op + 8 * g) = w0; *(v2u*)(op + 32 + 8 * g) = w1;
        }
    }
}
template <int B0> __device__ __forceinline__ bf16x8 cvt8(const f32x16& x) {
    v4u a; a.x = pg8::cvt_pk_bf16(x[B0 + 0], x[B0 + 1]); a.y = pg8::cvt_pk_bf16(x[B0 + 2], x[B0 + 3]); a.z = pg8::cvt_pk_bf16(x[B0 + 4], x[B0 + 5]); a.w = pg8::cvt_pk_bf16(x[B0 + 6], x[B0 + 7]); return __builtin_bit_cast(bf16x8, a); }
__device__ __forceinline__ bf16x8 mk8(const bf16* p) { const v2u lo = *(const v2u*)p, hi = *(const v2u*)(p + 8); v4u a; a.x = lo.x; a.y = lo.y; a.z = hi.x; a.w = hi.y; return __builtin_bit_cast(bf16x8, a); }
__device__ __forceinline__ void hgrn_update(f32x16 (&S)[4], const bf16* khp, const float* eglp, const bf16x8 (&idf)[2], const bf16x8 (&vf)[2]) {
#pragma unroll
    for (int i = 0; i < 4; ++i) {
#pragma unroll
        for (int g = 0; g < 4; ++g) { const f32x4 d = *(const f32x4*)(eglp + 32 * i + 8 * g); S[i][4 * g] *= d.x; S[i][4 * g + 1] *= d.y; S[i][4 * g + 2] *= d.z; S[i][4 * g + 3] *= d.w; }
        const bf16x8 a0 = *(const bf16x8*)(khp + 32 * i), a1 = *(const bf16x8*)(khp + 32 * i + 16);
        f32x16 X;
#pragma unroll
        for (int r = 0; r < 16; ++r) X[r] = 0.f;
        X = __builtin_amdgcn_mfma_f32_32x32x16_bf16(a0, idf[0], X, 0, 0, 0); X = __builtin_amdgcn_mfma_f32_32x32x16_bf16(a1, idf[1], X, 0, 0, 0);
        S[i] = __builtin_amdgcn_mfma_f32_32x32x16_bf16(cvt8<0>(X), vf[0], S[i], 0, 0, 0); S[i] = __builtin_amdgcn_mfma_f32_32x32x16_bf16(cvt8<8>(X), vf[1], S[i], 0, 0, 0);
    }
}
template <bool OUT> __device__ __forceinline__ void p2_hgrn(Frame& F) {
    const bf16* QT = (const bf16*)(F.ws + WS_QT); const bf16* KT = (const bf16*)(F.ws + WS_KT); const bf16* KH = (const bf16*)(F.ws + WS_KH); const bf16* VT = (const bf16*)(F.ws + WS_VT);
    const bf16* HGS = (const bf16*)(F.ws + WS_HGS); const float* EGL = (const float*)(F.ws + WS_EGL); float* SST = (float*)(F.ws + WS_SST); bf16* MIX = (bf16*)(F.ws + WS_MIXED);
    const int c = F.lane & 31, hh = F.lane >> 5, slot = F.wave >> 2, dvb = F.wave & 3;
    LAS float* red = (LAS float*)(F.lds);
    bf16x8 idf[2];
#pragma unroll
    for (int st = 0; st < 2; ++st) { v4u a; a.x = a.y = a.z = a.w = 0u; const int j = c - 16 * st - 8 * hh;
        if (j >= 0 && j < 8) { const unsigned one = (j & 1) ? 0x3F800000u : 0x00003F80u; if ((j >> 1) == 0) a.x = one; else if ((j >> 1) == 1) a.y = one; else if ((j >> 1) == 2) a.z = one; else a.w = one; }
        idf[st] = __builtin_bit_cast(bf16x8, a); }
    for (int ub = F.bx * 2; ub < NB * HGH * 16; ub += F.G * 2) {
        const int u = ub + slot, b = u >> 6, h = (u >> 4) & 3, jc = u & 15;
        const size_t tok0 = (size_t)b * SEQ + 256 * jc;
        float* sst = SST + ((size_t)(u * 4 + dvb) * 16) * 256 + F.lane * 4;
        f32x16 S[4];
        if (OUT) {
#pragma unroll
            for (int i = 0; i < 4; ++i)
#pragma unroll
                for (int g = 0; g < 4; ++g) { const f32x4 v = *(const f32x4*)(sst + (i * 4 + g) * 256); S[i][4 * g] = v.x; S[i][4 * g + 1] = v.y; S[i][4 * g + 2] = v.z; S[i][4 * g + 3] = v.w; }
        } else {
#pragma unroll
            for (int i = 0; i < 4; ++i)
#pragma unroll
                for (int r = 0; r < 16; ++r) S[i][r] = 0.f;
        }
        const bf16* vrow = VT + (size_t)(512 + h * 128 + 32 * dvb + c) * NTOK + tok0 + 4 * hh;
        for (int cs = 0; cs < 8; ++cs) {
            const size_t tokc = tok0 + 32 * cs;
            bf16x8 vf[2]; vf[0] = mk8(vrow + 32 * cs); vf[1] = mk8(vrow + 32 * cs + 16);
            const bf16* khp = KH + (tokc + c) * 512 + h * 128 + 8 * hh; const float* eglp = EGL + (tokc >> 5) * 512 + h * 128 + 4 * hh;
            if (OUT) {
                const bf16* qp = QT + (tokc + c) * 512 + h * 128 + 4 * hh; const bf16* kp = KT + (tokc + c) * 512 + h * 128 + 4 * hh;
                bf16x8 qf[8];
#pragma unroll
                for (int ks = 0; ks < 8; ++ks) qf[ks] = mk8(qp + 16 * ks);
                f32x16 P;
#pragma unroll
                for (int r = 0; r < 16; ++r) P[r] = 0.f;
#pragma unroll
                for (int ks = 0; ks < 8; ++ks) P = __builtin_amdgcn_mfma_f32_32x32x16_bf16(mk8(kp + 16 * ks), qf[ks], P, 0, 0, 0);
#pragma unroll
                for (int r = 0; r < 16; ++r) { const int srow = (r & 3) + 8 * (r >> 2) + 4 * hh; P[r] = (srow <= c) ? P[r] : 0.f; }
                f32x16 O;
#pragma unroll
                for (int r = 0; r < 16; ++r) O[r] = 0.f;
                O = __builtin_amdgcn_mfma_f32_32x32x16_bf16(vf[0], cvt8<0>(P), O, 0, 0, 0); O = __builtin_amdgcn_mfma_f32_32x32x16_bf16(vf[1], cvt8<8>(P), O, 0, 0, 0);
#pragma unroll
                for (int i = 0; i < 4; ++i) { O = __builtin_amdgcn_mfma_f32_32x32x16_bf16(cvt8<0>(S[i]), qf[2 * i], O, 0, 0, 0); O = __builtin_amdgcn_mfma_f32_32x32x16_bf16(cvt8<8>(S[i]), qf[2 * i + 1], O, 0, 0, 0); }
                float ss = 0.f;
#pragma unroll
                for (int r = 0; r < 16; ++r) ss += O[r] * O[r];
                ss += __shfl_xor(ss, 32);
                LAS float* rp = red + ((slot * 2 + (cs & 1)) * 4) * 32;
                if (hh == 0) rp[dvb * 32 + c] = ss;
                __syncthreads();
                const float tot = (rp[c] + rp[32 + c]) + (rp[64 + c] + rp[96 + c]);
                const float rs = 1.0f / sqrtf(tot * (1.f / 128.f) + EPS);
                const int dcol = h * 128 + 32 * dvb + 4 * hh;
                const bf16* gp = HGS + (tokc + c) * 512 + dcol; bf16* op = MIX + (tokc + c) * D + 512 + dcol;
#pragma unroll
                for (int g = 0; g < 4; ++g) { const v2u gs = *(const v2u*)(gp + 8 * g); const f32x4 gn = *(const f32x4*)(F.hg_gain + dcol + 8 * g);
                    v2u w; w.x = pg8::cvt_pk_bf16(O[4 * g] * rs * gn.x * bflo(gs.x), O[4 * g + 1] * rs * gn.y * bfhi(gs.x)); w.y = pg8::cvt_pk_bf16(O[4 * g + 2] * rs * gn.z * bflo(gs.y), O[4 * g + 3] * rs * gn.w * bfhi(gs.y));
                    *(v2u*)(op + 8 * g) = w; }
            }
            hgrn_update(S, khp, eglp, idf, vf);
        }
        if (!OUT) {
#pragma unroll
            for (int i = 0; i < 4; ++i)
#pragma unroll
                for (int g = 0; g < 4; ++g) *(f32x4*)(sst + (i * 4 + g) * 256) = (f32x4){S[i][4 * g], S[i][4 * g + 1], S[i][4 * g + 2], S[i][4 * g + 3]};
        }
    }
}
__device__ __forceinline__ void p2_hgrn_scan(Frame& F) {
    float* SST = (float*)(F.ws + WS_SST); const float* EGL = (const float*)(F.ws + WS_EGL); const float* MKH = (const float*)(F.ws + WS_META + META_MKH); const float* MP = (const float*)(F.ws + WS_META);
    for (int id = F.bx * 512 + F.tid; id < NB * HGH * 4096; id += F.G * 512) {
        const int bh = id >> 12, e4 = id & 4095, b = bh >> 2, h = bh & 3;
        const int ln = e4 & 63, g = (e4 >> 6) & 3, i = (e4 >> 8) & 3, dvb = e4 >> 10;
        const int dk = h * 128 + 32 * i + 8 * g + 4 * (ln >> 5), dv = h * 128 + 32 * dvb + (ln & 31);
        f32x4 s = (f32x4){0.f, 0.f, 0.f, 0.f};
        for (int r = 0; r < NMETA; ++r) { const f32x4 kk = *(const f32x4*)(MKH + r * 512 + dk); const float v = MP[(size_t)r * NPROJ + 2560 + dv]; s += kk * v; }
        for (int j = 0; j < 16; ++j) {
            float* p = SST + ((size_t)(bh * 16 + j) * 16384) + e4 * 4;
            const f32x4 loc = *(const f32x4*)p; *(f32x4*)p = s;
            f32x4 dt = (f32x4){1.f, 1.f, 1.f, 1.f};
#pragma unroll
            for (int cs = 0; cs < 8; ++cs) dt *= *(const f32x4*)(EGL + (size_t)(b * 128 + 8 * j + cs) * 512 + dk);
            s = dt * s + loc;
        }
    }
}
__device__ __forceinline__ void p4_router(Frame& F) {
    const bf16* HB = (const bf16*)(F.ws + WS_HB16); const bf16* WRT = (const bf16*)(F.ws + WS_WRT);
    unsigned* LT = (unsigned*)(F.ws + WS_LTOK); float* LGt = (float*)(F.ws + WS_LGATE); float* LRs = (float*)(F.ws + WS_LRSTD);
    LAS float* lg = (LAS float*)(F.lds) + F.wave * (16 * 48 + 16);
    volatile LAS int* M = (volatile LAS int*)F.MISC;
    const int fr = F.lane & 15, fq = F.lane >> 4;
    for (int tile = F.bx; tile < NTOK / 128; tile += F.G) {
        if (F.tid < NE) M[80 + F.tid] = 0;
        __syncthreads();
        const int row0 = tile * 128 + F.wave * 16;
        pg8::f32x4 acc[3]; acc[0] = acc[1] = acc[2] = (pg8::f32x4){0.f, 0.f, 0.f, 0.f}; float ss = 0.f;
        const bf16* ap = HB + (size_t)(row0 + fr) * D + 8 * fq; const bf16* bp = WRT + (size_t)fr * D + 8 * fq;
#pragma unroll 4
        for (int ks = 0; ks < 32; ++ks) {
            const bf16x8 a = *(const bf16x8*)(ap + 32 * ks);
            const v4u au = __builtin_bit_cast(v4u, a);
            ss += bflo(au.x) * bflo(au.x) + bfhi(au.x) * bfhi(au.x) + bflo(au.y) * bflo(au.y) + bfhi(au.y) * bfhi(au.y) + bflo(au.z) * bflo(au.z) + bfhi(au.z) * bfhi(au.z) + bflo(au.w) * bflo(au.w) + bfhi(au.w) * bfhi(au.w);
#pragma unroll
            for (int nt = 0; nt < 3; ++nt) { const bf16x8 bb = *(const bf16x8*)(bp + (size_t)nt * 16 * D + 32 * ks); acc[nt] = __builtin_amdgcn_mfma_f32_16x16x32_bf16(a, bb, acc[nt], 0, 0, 0); }
        }
        ss += __shfl_xor(ss, 16); ss += __shfl_xor(ss, 32);
#pragma unroll
        for (int nt = 0; nt < 3; ++nt)
#pragma unroll
            for (int j = 0; j < 4; ++j) lg[(fq * 4 + j) * 48 + nt * 16 + fr] = acc[nt][j];
        if (fq == 0) lg[16 * 48 + fr] = ss;
        __syncthreads();
        int e1 = 0, e2 = 0, r1 = 0, r2 = 0; float g1 = 0.f, g2 = 0.f, rstd = 0.f;
        if (F.lane < 16) {
            rstd = 1.0f / sqrtf(lg[16 * 48 + F.lane] * (1.f / D) + EPS);
            const LAS float* l = lg + F.lane * 48;
            float gl[4]; int gi = 0;
#pragma unroll
            for (int i = 0; i < 4; ++i) gl[i] = l[i] * rstd + F.b_rg[i];
#pragma unroll
            for (int i = 1; i < 4; ++i) if (gl[i] > gl[gi]) gi = i;
            float den = 0.f;
#pragma unroll
            for (int i = 0; i < 4; ++i) den += __expf(gl[i] - gl[gi]);
            const float pg = 1.0f / den;
            float v1 = -3.0e38f, v2 = -3.0e38f; int i1 = 0, i2 = 0;
            for (int i = 0; i < 8; ++i) { const float v = l[4 + gi * 8 + i] * rstd + F.b_re[gi * 8 + i]; if (v > v1) { v2 = v1; i2 = i1; v1 = v; i1 = i; } else if (v > v2) { v2 = v; i2 = i; } }
            const float ex = __expf(v2 - v1); g1 = pg / (1.f + ex); g2 = pg * ex / (1.f + ex);
            e1 = gi * 8 + i1; e2 = gi * 8 + i2;
            r1 = __hip_atomic_fetch_add((LAS int*)&M[80 + e1], 1, __ATOMIC_RELAXED, __HIP_MEMORY_SCOPE_WORKGROUP); r2 = __hip_atomic_fetch_add((LAS int*)&M[80 + e2], 1, __ATOMIC_RELAXED, __HIP_MEMORY_SCOPE_WORKGROUP);
        }
        __syncthreads();
        if (F.tid < NE) { const int n = M[80 + F.tid]; M[120 + F.tid] = n ? (int)__hip_atomic_fetch_add(F.ctl + CW_CNT + 64 * F.tid, (unsigned)n, RLX_AGENT) : 0; }
        __syncthreads();
        if (F.lane < 16) { const unsigned tok = (unsigned)(row0 + F.lane);
            const size_t p1 = (size_t)e1 * LCAP + M[120 + e1] + r1, p2 = (size_t)e2 * LCAP + M[120 + e2] + r2;
            LT[p1] = tok; LGt[p1] = g1; LRs[p1] = rstd; LT[p2] = tok | 0x40000000u; LGt[p2] = g2; LRs[p2] = rstd; }
        __syncthreads();
    }
}
__device__ __forceinline__ void p7_final(Frame& F) {
    const float* H = (const float*)(F.ws + WS_H); const bf16* Y0 = (const bf16*)(F.ws + WS_Y0); const bf16* Y1 = (const bf16*)(F.ws + WS_Y1);
    const int gw = F.bx * NWAVES + F.wave, NGW = F.G * NWAVES;
    f32x4 gf[4];
#pragma unroll
    for (int j = 0; j < 4; ++j) gf[j] = *(const f32x4*)(F.g_final + 4 * F.lane + 256 * j);
    for (int m = gw; m < NTOK; m += NGW) {
        const GAS f32x4* hr = (const GAS f32x4*)(H + (size_t)m * D) + F.lane; const GAS v2u* y0 = (const GAS v2u*)(Y0 + (size_t)m * D) + F.lane; const GAS v2u* y1 = (const GAS v2u*)(Y1 + (size_t)m * D) + F.lane;
        f32x4 v[4]; float s = 0.f;
#pragma unroll
        for (int j = 0; j < 4; ++j) { v[j] = hr[64 * j]; const v2u a = y0[64 * j], b = y1[64 * j];
            v[j].x += bflo(a.x) + bflo(b.x); v[j].y += bfhi(a.x) + bfhi(b.x); v[j].z += bflo(a.y) + bflo(b.y); v[j].w += bfhi(a.y) + bfhi(b.y);
            s += (v[j].x * v[j].x + v[j].y * v[j].y) + (v[j].z * v[j].z + v[j].w * v[j].w); }
        const float rstd = 1.0f / sqrtf(wave_sum(s) * (1.f / D) + EPS);
        GAS f32x4* o = (GAS f32x4*)(F.out + (size_t)m * D) + F.lane;
#pragma unroll
        for (int j = 0; j < 4; ++j) o[64 * j] = v[j] * rstd * gf[j];
    }
}

constexpr int NPHASES = 10;
__global__ void __launch_bounds__(NWAVES * 64, 2) hymba_fwd(Args args) {
    extern __shared__ __attribute__((aligned(16))) unsigned char lds[];
    Frame F;
    F.lds = (LAS unsigned char*)lds; F.MISC = (volatile LAS unsigned*)(F.lds + MISC_OFF);
    F.tid = threadIdx.x; F.lane = F.tid & 63; F.wave = __builtin_amdgcn_readfirstlane(F.tid >> 6); F.G = gridDim.x; F.bx = blockIdx.x;
    F.ws = args.ws; F.ctl = (gu32*)(args.ws + WS_CTL); F.out = args.out;
    F.x = args.in[0]; F.meta = args.in[1]; F.lb_logits = args.in[2]; F.g_mix = args.in[3]; F.w_in = args.in[4]; F.sb_gain = args.in[5]; F.hg_gain = args.in[6]; F.w_out = args.in[7]; F.g_ffn = args.in[8];
    F.w_rg = args.in[9]; F.b_rg = args.in[10]; F.w_re = args.in[11]; F.b_re = args.in[12]; F.w_gate = args.in[13]; F.w_up = args.in[14]; F.w_down = args.in[15]; F.g_final = args.in[16];
    for (int u = F.tid; u < 256; u += NWAVES * 64) F.MISC[u] = 0u;
    __syncthreads();
#if !MK_PER_PHASE
    XcdBarrier bar = xcd_barrier_post((unsigned*)(F.ctl + CW_BAR), F.MISC + 200);
#define GRID_BAR() xcd_barrier(bar)
#else
#define GRID_BAR() do {} while (0)
#endif
    const int lo = args.ph_lo, hi = args.ph_hi;
#define IN(k) (lo <= (k) && (k) < hi)
#define BOTH(k) (IN(k) && IN((k) + 1))
    unsigned char* ws = args.ws;

#ifndef SKIP_P0
    if (IN(0)) { p0_prologue(F); if (BOTH(0)) GRID_BAR(); }
#endif

#ifndef SKIP_P1
    if (IN(1)) {
        { pg8::StaticOrder S; S.init(ws + WS_XB, ws + WS_WIN, NTOK, 2560, D, F.G, F.bx);
          EpiInProj E{(const float*)(ws + WS_RSTD1), (const float*)(ws + WS_META + META_LB), (bf16*)(ws + WS_QK), (bf16*)(ws + WS_QT), (bf16*)(ws + WS_KT), (bf16*)(ws + WS_KH), (float*)(ws + WS_EGL), (bf16*)(ws + WS_HGS)};
          pg8::gemm_phase<EpiInProj, pg8::StaticOrder>(F.lds + RING_OFF, D, S, E); }
        { pg8::StaticOrder S; S.init(ws + WS_WIN + (size_t)2560 * D * 2, ws + WS_XB, 1024, NTOK, D, F.G, F.bx);
          EpiVT E{(const float*)(ws + WS_RSTD1), (bf16*)(ws + WS_VT)};
          pg8::gemm_phase<EpiVT, pg8::StaticOrder>(F.lds + RING_OFF, D, S, E); }
        if (BOTH(1)) GRID_BAR();
    }
#endif
#ifndef SKIP_P2
    if (IN(2)) { p2_hgrn<false>(F); p2_attention(F); if (BOTH(2)) GRID_BAR(); }
    if (IN(3)) { p2_hgrn_scan(F); if (BOTH(3)) GRID_BAR(); }
    if (IN(4)) { p2_hgrn<true>(F); if (BOTH(4)) GRID_BAR(); }
#endif
#ifndef SKIP_P3
    if (IN(5)) {
        pg8::StaticOrder S; S.init(ws + WS_MIXED, ws + WS_WOUT, NTOK, D, D, F.G, F.bx);
        EpiOutProj E{F.x, (float*)(ws + WS_H), (bf16*)(ws + WS_HB16)};
        pg8::gemm_phase<EpiOutProj, pg8::StaticOrder>(F.lds + RING_OFF, D, S, E);
        if (BOTH(5)) GRID_BAR();
    }
#endif
#ifndef SKIP_P4
    if (IN(6)) { p4_router(F); if (BOTH(6)) GRID_BAR(); }
#endif

#ifndef SKIP_P5
    if (IN(7)) {
        const int nunits = moe_setup(F, 0);
        MoeOrder<true> S{(const LAS int*)F.MISC, (const LAS int*)F.MISC + 40, (const LAS unsigned*)(F.lds + LIST_OFF), (const char*)(ws + WS_HB16), (const char*)(ws + WS_WGU), D, F.G, F.bx, nunits};
        EpiGateUp E{(const LAS float*)(F.lds + LIST_OFF + 8192), (bf16*)(ws + WS_HBUF)};
        pg8::gemm_phase<EpiGateUp, MoeOrder<true>>(F.lds + RING_OFF, D, S, E);
        if (BOTH(7)) GRID_BAR();
    }
#endif
#ifndef SKIP_P6
    if (IN(8)) {
        const int nunits = moe_setup(F, 1);
        MoeOrder<false> S{(const LAS int*)F.MISC, (const LAS int*)F.MISC + 40, (const LAS unsigned*)(F.lds + LIST_OFF), (const char*)(ws + WS_HBUF), (const char*)(ws + WS_WDN), FF, F.G, F.bx, nunits};
        EpiDown E{(const LAS unsigned*)(F.lds + LIST_OFF), (const LAS float*)(F.lds + LIST_OFF + 8192), (bf16*)(ws + WS_Y0), (bf16*)(ws + WS_Y1)};
        pg8::gemm_phase<EpiDown, MoeOrder<false>>(F.lds + RING_OFF, FF, S, E);
        if (BOTH(8)) GRID_BAR();
    }
#endif
#ifndef SKIP_P7
    if (IN(9)) p7_final(F);
#endif
#undef IN
#undef BOTH
}

extern "C" void kernel_launch(void* const* d_in, const int* in_sizes, int n_in, void* d_out, int out_size, void* d_ws, size_t ws_size, hipStream_t stream) {
    static int grid = 0;
    if (grid == 0) {
        if (n_in != 17 || in_sizes[0] != NTOK * D || out_size != NTOK * D || ws_size < WS_END) { fprintf(stderr, "kernel_launch: unexpected shapes (n_in %d, in0 %d, out %d, ws %zu)\n", n_in, n_in > 0 ? in_sizes[0] : -1, out_size, ws_size); grid = -1; return; }
        int dev = 0, cus = 0, per_cu = 0;
        if (hipGetDevice(&dev) != hipSuccess || hipDeviceGetAttribute(&cus, hipDeviceAttributeMultiprocessorCount, dev) != hipSuccess) { grid = -1; return; }
        if (hipFuncSetAttribute((const void*)hymba_fwd, hipFuncAttributeMaxDynamicSharedMemorySize, LDS_BYTES) != hipSuccess) { fprintf(stderr, "kernel_launch: hipFuncSetAttribute failed\n"); grid = -1; return; }
        if (hipOccupancyMaxActiveBlocksPerMultiprocessor(&per_cu, (const void*)hymba_fwd, NWAVES * 64, LDS_BYTES) != hipSuccess || per_cu < 1) { fprintf(stderr, "kernel_launch: occupancy query says %d\n", per_cu); }
        (void)hipGetLastError();
        grid = cus;
    }
    if (grid < 0) return;
    hipMemsetAsync((char*)d_ws + WS_CTL, 0, CTL_ZERO_BYTES, stream);
    Args a{};
    for (int i = 0; i < 17; ++i) a.in[i] = (const float*)d_in[i];
    a.out = (float*)d_out; a.ws = (unsigned char*)d_ws;
#if MK_PER_PHASE
    for (int p = 0; p < NPHASES; ++p) { a.ph_lo = p; a.ph_hi = p + 1; hipLaunchKernelGGL(hymba_fwd, dim3(grid), dim3(NWAVES * 64), LDS_BYTES, stream, a); }
#else
    a.ph_lo = 0; a.ph_hi = NPHASES; hipLaunchKernelGGL(hymba_fwd, dim3(grid), dim3(NWAVES * 64), LDS_BYTES, stream, a);
#endif
}
```

```cpp
#include <hip/hip_runtime.h>
#include <cstdio>
#include <cstdint>

#define PROBE_RELAUNCH (-1)
#define PROBE_DUP 0
#define MK_PER_PHASE 0

namespace pg8 {
#define PG8_LAS __attribute__((address_space(3)))
typedef unsigned short bf16_t;
typedef short bf16x8 __attribute__((ext_vector_type(8)));
typedef float f32x4 __attribute__((ext_vector_type(4)));
typedef unsigned u32x4 __attribute__((ext_vector_type(4)));
constexpr int BM = 256, BK = 64, HALF = 128, HTB = HALF * BK * 2  , STAGE_BYTES = 8 * HTB, NXCD = 8, WGM = 8;

__host__ __device__ __forceinline__ int lds_byte(int r, int c) { const int st = (r >> 4) * 2 + (c >> 5), rr = r & 15, cc = c & 31, ob = rr * 64 + cc * 2; return st * 1024 + (ob ^ (((ob >> 9) & 1) << 5)); }
__host__ __device__ __forceinline__ void stage_rc(int b, int& R, int& C) { const int st = b / 1024, sb = b % 1024, swz = sb ^ (((sb >> 9) & 1) << 5); R = (st >> 1) * 16 + swz / 64; C = (st & 1) * 32 + (swz % 64) / 2; }
__host__ __device__ __forceinline__ int perm32(int rho) { const int n = rho >> 4, i = rho & 15; return 8 * (i >> 2) + 4 * n + (i & 3); }

struct Unit { int pm, pn, e, rows; };

struct StaticOrder {
    const char* A; const char* Bt; int K, nM, nN, nwg, G, c;
    __device__ void init(const void* A_, const void* Bt_, int M, int N, int K_, int G_, int c_) { A = (const char*)A_; Bt = (const char*)Bt_; K = K_; nM = M / BM; nN = N / BM; nwg = nM * nN; G = G_; c = c_; }
    __device__ bool next(int i, Unit& u) const {
        const long L = (long)i * G + c; if (L >= nwg) return false;
        int wgid = (int)L; { const int q = nwg / NXCD, r = nwg % NXCD, xcd = wgid % NXCD, off = wgid / NXCD; wgid = (xcd < r ? xcd * (q + 1) : r * (q + 1) + (xcd - r) * q) + off; }
        const int nig = WGM * nN, gid = wgid / nig, fm = gid * WGM, gsz = (nM - fm) < WGM ? (nM - fm) : WGM;
        u.pm = fm + ((wgid % nig) % gsz); u.pn = (wgid % nig) / gsz; u.e = 0; u.rows = BM; return true;
    }
    __device__ __forceinline__ const char* a_base(const Unit& u) const { return A + (size_t)u.pm * BM * K * 2; }
    __device__ __forceinline__ const char* b_base(const Unit& u) const { return Bt + (size_t)u.pn * BM * K * 2; }
    __device__ __forceinline__ void a_off(const Unit&, int, const int (&sR)[2], const int (&sC)[2], unsigned (&g)[2][2]) const {
#pragma unroll
        for (int h = 0; h < 2; ++h)
#pragma unroll
            for (int i = 0; i < 2; ++i) g[h][i] = (unsigned)((h * HALF + sR[i]) * K + sC[i]) * 2u;
    }
};

__device__ __forceinline__ unsigned cvt_pk_bf16(float lo, float hi) { unsigned r; asm volatile("v_cvt_pk_bf16_f32 %0, %1, %2" : "=v"(r) : "v"(lo), "v"(hi)); return r; }

template <class Epi, class Sched>
__device__ __forceinline__ void gemm_phase(PG8_LAS unsigned char* lds, const int K, const Sched& S, const Epi& E) {
    const int tid = threadIdx.x, wid = __builtin_amdgcn_readfirstlane(tid >> 6), lane = tid & 63, wr = wid >> 2, wc = wid & 3, fr = lane & 15, fq = lane >> 4;
    const int nt = K / BK;
    unsigned voffB[2]; int sR[2], sC[2];
#pragma unroll
    for (int i = 0; i < 2; ++i) { int R, C; stage_rc(tid * 16 + i * 8192, R, C); sR[i] = R; sC[i] = C; const int Rb = Epi::PERM ? ((R & ~31) + perm32(R & 31)) : R; voffB[i] = (unsigned)(Rb * K + C) * 2u; }
    const size_t kstep = (size_t)(BK * 2);
    const size_t hstep = (size_t)HALF * K * 2;
    const unsigned ldsw = (unsigned)wid * 1024u;
    const int aoff = lds_byte(wr * 64 + fr, fq * 8), boff = lds_byte(wc * 32 + fr, fq * 8);
#define PG8_SA(b, h) (((b) * 2 + (h)) * HTB)
#define PG8_SB(b, h) ((4 + (b) * 2 + (h)) * HTB)
#define PG8_STAGE(bufoff, gbase, voff) do { _Pragma("unroll") for (int _i = 0; _i < 2; ++_i) \
        __builtin_amdgcn_global_load_lds((const unsigned*)((const char*)(gbase) + (voff)[_i]), (PG8_LAS unsigned*)(lds + (bufoff) + ldsw + _i * 8192), 16, 0, 0); } while (0)
#define PG8_LDA(dst, b, h) do { _Pragma("unroll") for (int m = 0; m < 4; ++m) _Pragma("unroll") for (int k = 0; k < 2; ++k) dst[m][k] = *(const PG8_LAS bf16x8*)(lds + PG8_SA(b, h) + aoff + m * 2048 + k * 1024); } while (0)
#define PG8_LDB(dst, b, h) do { _Pragma("unroll") for (int n = 0; n < 2; ++n) _Pragma("unroll") for (int k = 0; k < 2; ++k) dst[n][k] = *(const PG8_LAS bf16x8*)(lds + PG8_SB(b, h) + boff + n * 2048 + k * 1024); } while (0)
#define PG8_MMA(ai, bj, At, Bt) do { __builtin_amdgcn_s_setprio(1); _Pragma("unroll") for (int m = 0; m < 4; ++m) _Pragma("unroll") for (int n = 0; n < 2; ++n) _Pragma("unroll") for (int k = 0; k < 2; ++k) \
        acc[ai][bj][m][n] = __builtin_amdgcn_mfma_f32_16x16x32_bf16(Bt[n][k], At[m][k], acc[ai][bj][m][n], 0, 0, 0); __builtin_amdgcn_s_setprio(0); } while (0)
#define PG8_WAIT_V(n) asm volatile("s_waitcnt vmcnt(" #n ")" ::: "memory")
#define PG8_WAIT_L(n) asm volatile("s_waitcnt lgkmcnt(" #n ")" ::: "memory")
#define PG8_BAR __builtin_amdgcn_s_barrier()
#define PG8_SCHED __builtin_amdgcn_sched_barrier(0)
    Unit cur, nxt; int ui = 0;
    if (!S.next(0, cur)) return;
    f32x4 acc[2][2][4][2];
#pragma unroll
    for (int a = 0; a < 2; ++a)
#pragma unroll
        for (int b = 0; b < 2; ++b)
#pragma unroll
            for (int m = 0; m < 4; ++m)
#pragma unroll
                for (int n = 0; n < 2; ++n) acc[a][b][m][n] = (f32x4){0.f, 0.f, 0.f, 0.f};
    bf16x8 At[4][2], B0[2][2], B1[2][2];
    unsigned gc[2][2], gn[2][2];
    S.a_off(cur, 0, sR, sC, gc);
#pragma unroll
    for (int h = 0; h < 2; ++h)
#pragma unroll
        for (int i = 0; i < 2; ++i) gn[h][i] = gc[h][i];
    const char* cA = S.a_base(cur); const char* cB = S.b_base(cur);
    PG8_STAGE(PG8_SB(0, 0), cB, voffB); PG8_STAGE(PG8_SA(0, 0), cA, gc[0]); PG8_STAGE(PG8_SB(0, 1), cB + hstep, voffB); PG8_STAGE(PG8_SA(0, 1), cA, gc[1]);
    if (wr == 1) PG8_BAR;
    PG8_WAIT_V(4); PG8_BAR;
    PG8_STAGE(PG8_SB(1, 0), cB + kstep, voffB); PG8_STAGE(PG8_SA(1, 0), cA + kstep, gc[0]); PG8_STAGE(PG8_SB(1, 1), cB + hstep + kstep, voffB);
    PG8_WAIT_V(6); PG8_BAR;
    for (;;) {
        const bool has_next = S.next(ui + 1, nxt);
        const char* nA = has_next ? S.a_base(nxt) : cA; const char* nB = has_next ? S.b_base(nxt) : cB;
        for (int t = 0; t < nt; t += 2) {
            const bool last = (t == nt - 2);
            const char* a1 = cA + (size_t)(t + 1) * kstep;
            const char* a2 = last ? nA : cA + (size_t)(t + 2) * kstep; const char* b2 = last ? nB : cB + (size_t)(t + 2) * kstep;
            const char* a3 = a2 + kstep; const char* b3 = b2 + kstep;
            if (last && has_next) S.a_off(nxt, ui + 1, sR, sC, gn);
            unsigned g2[2][2];
#pragma unroll
            for (int h = 0; h < 2; ++h)
#pragma unroll
                for (int i = 0; i < 2; ++i) g2[h][i] = last ? gn[h][i] : gc[h][i];
            PG8_LDB(B0, 0, 0); PG8_SCHED; PG8_LDA(At, 0, 0); PG8_STAGE(PG8_SA(1, 1), a1, gc[1]);
            PG8_WAIT_L(8); PG8_BAR; PG8_WAIT_L(0); PG8_MMA(0, 0, At, B0); PG8_BAR; PG8_SCHED;
            PG8_LDB(B1, 0, 1); PG8_STAGE(PG8_SB(0, 0), b2, voffB);
            PG8_BAR; PG8_WAIT_L(0); PG8_MMA(0, 1, At, B1); PG8_BAR;
            PG8_LDA(At, 0, 1); PG8_STAGE(PG8_SA(0, 0), a2, g2[0]);
            PG8_BAR; PG8_WAIT_L(0); PG8_MMA(1, 0, At, B0); PG8_BAR; PG8_SCHED;
            PG8_STAGE(PG8_SB(0, 1), b2 + hstep, voffB);
            PG8_WAIT_V(6); PG8_BAR; PG8_MMA(1, 1, At, B1); PG8_BAR;
            PG8_LDB(B0, 1, 0); PG8_SCHED; PG8_LDA(At, 1, 0); PG8_STAGE(PG8_SA(0, 1), a2, g2[1]);
            PG8_WAIT_L(8); PG8_BAR; PG8_WAIT_L(0); PG8_MMA(0, 0, At, B0); PG8_BAR; PG8_SCHED;
            PG8_LDB(B1, 1, 1); PG8_STAGE(PG8_SB(1, 0), b3, voffB);
            PG8_BAR; PG8_WAIT_L(0); PG8_MMA(0, 1, At, B1); PG8_BAR;
            PG8_LDA(At, 1, 1); PG8_STAGE(PG8_SA(1, 0), a3, g2[0]);
            PG8_BAR; PG8_WAIT_L(0); PG8_MMA(1, 0, At, B0); PG8_BAR; PG8_SCHED;
            PG8_STAGE(PG8_SB(1, 1), b3 + hstep, voffB);
            PG8_WAIT_V(6); PG8_BAR; PG8_MMA(1, 1, At, B1); PG8_BAR;
        }
        E(acc, cur, ui, wr, wc, fr, fq);
        if (!has_next) break;
#pragma unroll
        for (int a = 0; a < 2; ++a)
#pragma unroll
            for (int b = 0; b < 2; ++b)
#pragma unroll
                for (int m = 0; m < 4; ++m)
#pragma unroll
                    for (int n = 0; n < 2; ++n) acc[a][b][m][n] = (f32x4){0.f, 0.f, 0.f, 0.f};
        cur = nxt; cA = nA; cB = nB; ++ui;
#pragma unroll
        for (int h = 0; h < 2; ++h)
#pragma unroll
            for (int i = 0; i < 2; ++i) gc[h][i] = gn[h][i];
    }
    PG8_WAIT_V(0);
    if (wr == 0) PG8_BAR;
    PG8_BAR;
#undef PG8_SA
#undef PG8_SB
#undef PG8_STAGE
#undef PG8_LDA
#undef PG8_LDB
#undef PG8_MMA
#undef PG8_WAIT_V
#undef PG8_WAIT_L
#undef PG8_BAR
#undef PG8_SCHED
}
}

constexpr int NWAVES = 8;
constexpr int NB = 8, SEQ = 4096, D = 1024, NTOK = NB * SEQ, NPROJ = 3584, NMETA = 16;
constexpr int SBH = 8, SBD = 64, HGH = 4, HGD = 128;
constexpr int NE = 32, FF = 512, LCAP = NTOK;
constexpr float EPS = 1e-6f;
constexpr float QSCALE = 0.125f * 1.4426950408889634f;

constexpr size_t MiB = 1u << 20;
constexpr size_t WS_CTL = 0, CTL_ZERO_BYTES = 1 * MiB;
constexpr size_t WS_WIN = 1 * MiB, WS_WOUT = 8 * MiB, WS_WRT = 10 * MiB, WS_WGU = 11 * MiB, WS_WDN = 75 * MiB;
constexpr size_t WS_META = 107 * MiB;
constexpr size_t WS_RSTD1 = 108 * MiB;
constexpr size_t WS_LTOK = 109 * MiB, WS_LGATE = 113 * MiB, WS_LRSTD = 117 * MiB;
constexpr size_t WS_XB = 121 * MiB;
constexpr size_t WS_MIXED = WS_XB, WS_HBUF = WS_XB;
constexpr size_t WS_SQ = 193 * MiB, WS_SK = 225 * MiB, WS_VT = 257 * MiB, WS_QT = 321 * MiB, WS_KT = 353 * MiB, WS_KH = 385 * MiB, WS_HGS = 417 * MiB, WS_SST = 449 * MiB;
constexpr size_t WS_EGL = 109 * MiB;
constexpr size_t META_LB = 256 * 1024, META_KM = 320 * 1024, META_VTM = 352 * 1024, META_MKH = 384 * 1024;
constexpr size_t META_DUMMY0 = 0;
constexpr size_t WS_H = 193 * MiB, WS_HB16 = 321 * MiB;
constexpr size_t WS_Y0 = 321 * MiB, WS_Y1 = 385 * MiB;
constexpr size_t WS_END = 481 * MiB;
constexpr int CW_TMO = 0, CW_CODE = 1, CW_BAR = 4096, CW_CNT = 8192;

constexpr int RING_OFF = 0, RING_BYTES = 131072;
constexpr int LIST_OFF = RING_BYTES, LIST_BYTES = 16384;
constexpr int MISC_OFF = LIST_OFF + LIST_BYTES;
constexpr int LDS_BYTES = MISC_OFF + 1024;
static_assert(LDS_BYTES <= 160 * 1024, "LDS");

#define GAS __attribute__((address_space(1)))
#define LAS __attribute__((address_space(3)))
typedef unsigned short bf16;
typedef unsigned v4u __attribute__((ext_vector_type(4)));
typedef unsigned v2u __attribute__((ext_vector_type(2)));
typedef float f32x4 __attribute__((ext_vector_type(4)));
typedef short bf16x8 __attribute__((ext_vector_type(8)));
typedef GAS unsigned gu32;
#define RLX_AGENT __ATOMIC_RELAXED, __HIP_MEMORY_SCOPE_AGENT
#define LDS_WAIT() asm volatile("s_waitcnt lgkmcnt(0)" ::: "memory")
__device__ __forceinline__ unsigned f2bf(float f) { unsigned u = __builtin_bit_cast(unsigned, f); return (u + 0x7fffu + ((u >> 16) & 1u)) >> 16; }
__device__ __forceinline__ unsigned pk2(float lo, float hi) { return f2bf(lo) | (f2bf(hi) << 16); }
__device__ __forceinline__ float bflo(unsigned u) { return __builtin_bit_cast(float, u << 16); }
__device__ __forceinline__ float bfhi(unsigned u) { return __builtin_bit_cast(float, u & 0xffff0000u); }
__device__ __forceinline__ float silu_f(float x) { return x * __builtin_amdgcn_rcpf(1.0f + __expf(-x)); }
__device__ __forceinline__ size_t frag_off(int chunk, int kg, int hh, int r) { return ((((size_t)chunk * 32 + kg) * 2 + hh) * 32 + r) * 8; }
__device__ __forceinline__ size_t vtf_off(int rb, int nch, int chunk, int sx, int hh, int c) { return (((((size_t)rb * nch + chunk) * 2 + sx) * 2 + hh) * 32 + c) * 8; }
__device__ __forceinline__ float wave_sum(float v) {
#pragma unroll
    for (int o = 1; o < 64; o <<= 1) v += __shfl_xor(v, o);
    return v;
}

#define XB_TMO      128
#define XB_XCNT(j)  (256  + 64 * (j))
#define XB_XSUB(j)  (1280 + 64 * (j))
#define XB_XGEN(j)  (2304 + 64 * (j))
#define XB_TOP      3328
#define XB_TOPGEN   3392
#define XCD_BAR_WORDS 3456
#define XB_SPIN_CAP (1u << 18)
__device__ __forceinline__ unsigned xb_ld(unsigned* p)              { return __hip_atomic_load(p, __ATOMIC_RELAXED, __HIP_MEMORY_SCOPE_AGENT); }
__device__ __forceinline__ unsigned xb_add(unsigned* p, unsigned v) { return __hip_atomic_fetch_add(p, v, __ATOMIC_RELAXED, __HIP_MEMORY_SCOPE_AGENT); }
__device__ __forceinline__ unsigned xb_xcc_id() { return (unsigned)__builtin_amdgcn_s_getreg((3 << 11) | 20) & 0xFu; }
#define XB_SPIN(cond, bar) do { unsigned _sp = 0; while (cond) { __builtin_amdgcn_s_sleep(1); \
    if ((++_sp & 255u) == 0u) { if (xb_ld(&(bar)[XB_TMO])) break; if (_sp > XB_SPIN_CAP) { atomicAdd(&(bar)[XB_TMO], 1u); break; } } } } while (0)
struct XcdBarrier { unsigned* bar; unsigned x; volatile LAS unsigned* st; };
__device__ __forceinline__ XcdBarrier xcd_barrier_post(unsigned* bar, volatile LAS unsigned* st) {
    XcdBarrier b; b.bar = bar; b.x = xb_xcc_id(); b.st = st;
    if (threadIdx.x == 0) (void)xb_add(&bar[XB_XCNT(b.x)], 1u);
    return b;
}
__device__ __forceinline__ void xcd_barrier_complete(unsigned* bar, unsigned x, unsigned& nloc, unsigned& nx) {
    const unsigned G = gridDim.x * gridDim.y * gridDim.z;
    unsigned sum, cnt, mine, sp = 0u;
    for (;;) {
        sum = 0u; cnt = 0u; mine = 0u;
#pragma unroll
        for (unsigned j = 0; j < 16; ++j) { const unsigned c = xb_ld(&bar[XB_XCNT(j)]); sum += c; cnt += (c > 0u) ? 1u : 0u; mine = (j == x) ? c : mine; }
        if (sum == G) break;
        __builtin_amdgcn_s_sleep(1);
        if ((++sp & 255u) == 0u) { if (xb_ld(&bar[XB_TMO])) break; if (sp > XB_SPIN_CAP) { atomicAdd(&bar[XB_TMO], 1u); break; } }
    }
    nloc = mine > 0u ? mine : 1u; nx = cnt > 0u ? cnt : 1u;
}
__device__ __forceinline__ void xcd_barrier(const XcdBarrier& b) {
    asm volatile("s_waitcnt vmcnt(0)" ::: "memory");
    __syncthreads();
    if (threadIdx.x == 0) {
        unsigned* bar = b.bar;
        __builtin_amdgcn_s_waitcnt(0);
        unsigned nloc = b.st[0], nx = b.st[1];
        if (nloc == 0u) { xcd_barrier_complete(bar, b.x, nloc, nx); b.st[0] = nloc; b.st[1] = nx; }
        const unsigned old = xb_add(&bar[XB_XSUB(b.x)], 1u);
        const unsigned gen = old / nloc;
        if (old + 1u == (gen + 1u) * nloc) {
            __builtin_amdgcn_fence(__ATOMIC_RELEASE, "agent");
            asm volatile("s_waitcnt vmcnt(0)" ::: "memory");
            const unsigned og = xb_add(&bar[XB_TOP], 1u);
            const unsigned tg = og / nx;
            if (og + 1u == (tg + 1u) * nx) xb_add(&bar[XB_TOPGEN], 1u);
            else XB_SPIN(xb_ld(&bar[XB_TOPGEN]) == tg, bar);
            __builtin_amdgcn_fence(__ATOMIC_ACQUIRE, "agent");
            xb_add(&bar[XB_XGEN(b.x)], 1u);
            asm volatile("s_waitcnt vmcnt(0)" ::: "memory");
        } else {
            XB_SPIN(xb_ld(&bar[XB_XGEN(b.x)]) == gen, bar);
            __builtin_amdgcn_fence(__ATOMIC_ACQUIRE, "agent");
            asm volatile("s_waitcnt vmcnt(0)" ::: "memory");
        }
    }
    __syncthreads();
}

struct Args { const float* in[17]; float* out; unsigned char* ws; int ph_lo, ph_hi; };
struct Frame {
    LAS unsigned char* lds; volatile LAS unsigned* MISC; gu32* ctl; unsigned char* ws;
    int tid, lane, wave, G, bx;
    const float *x, *meta, *lb_logits, *g_mix, *w_in, *sb_gain, *hg_gain, *w_out, *g_ffn, *w_rg, *b_rg, *w_re, *b_re, *w_gate, *w_up, *w_down, *g_final;
    float* out;
};

__device__ __forceinline__ void p0_transpose_item(const float* W, int ldw, int srcc0, int k0, bf16* WT, int Kd, int dstr0, const float* gain, LAS float* scr, int lane) {
    float v[32]; const float* wp = W + (size_t)(k0 + (lane >> 5)) * ldw + srcc0 + (lane & 31);
#pragma unroll
    for (int i = 0; i < 32; ++i) v[i] = wp[(size_t)(2 * i) * ldw];
    if (gain) {
#pragma unroll
        for (int i = 0; i < 32; ++i) v[i] *= gain[k0 + 2 * i + (lane >> 5)]; }
#pragma unroll
    for (int i = 0; i < 32; ++i) scr[(2 * i + (lane >> 5)) * 33 + (lane & 31)] = v[i];
    LDS_WAIT(); asm volatile("" ::: "memory");
    const int c = lane & 7;
#pragma unroll
    for (int j = 0; j < 4; ++j) { const int n = (lane >> 3) + 8 * j; const LAS float* s = scr + (8 * c) * 33 + n;
        v4u o; o.x = pk2(s[0 * 33], s[1 * 33]); o.y = pk2(s[2 * 33], s[3 * 33]); o.z = pk2(s[4 * 33], s[5 * 33]); o.w = pk2(s[6 * 33], s[7 * 33]);
        *(GAS v4u*)(WT + (size_t)(dstr0 + n) * Kd + k0 + 8 * c) = o; }
    LDS_WAIT(); asm volatile("" ::: "memory");
}
__device__ __forceinline__ void p0_prologue(Frame& F) {
    unsigned char* ws = F.ws;
    const int gw = F.bx * NWAVES + F.wave, NGW = F.G * NWAVES;
    {
        LAS float* am = (LAS float*)(F.lds);
        LAS float* red = (LAS float*)(F.lds + 65536);
        for (int r = F.wave * 2; r < F.wave * 2 + 2; ++r) {
            const GAS f32x4* xr = (const GAS f32x4*)(F.meta + (size_t)r * D) + F.lane; f32x4 v[4]; float s = 0.f;
#pragma unroll
            for (int j = 0; j < 4; ++j) { v[j] = xr[64 * j]; s += (v[j].x * v[j].x + v[j].y * v[j].y) + (v[j].z * v[j].z + v[j].w * v[j].w); }
            const float rstd = 1.0f / sqrtf(wave_sum(s) * (1.f / D) + EPS);
#pragma unroll
            for (int j = 0; j < 4; ++j) { const int k = 4 * F.lane + 256 * j; const f32x4 g = *(const GAS f32x4*)(F.g_mix + k);
                am[r * D + k + 0] = v[j].x * rstd * g.x; am[r * D + k + 1] = v[j].y * rstd * g.y; am[r * D + k + 2] = v[j].z * rstd * g.z; am[r * D + k + 3] = v[j].w * rstd * g.w; }
        }
        __syncthreads();
        for (int cb = F.bx; cb < NPROJ / 14; cb += F.G) {
            if (F.tid < 448) { const int c = F.tid % 14, ks = F.tid / 14, col = cb * 14 + c; float a[16];
#pragma unroll
                for (int r = 0; r < 16; ++r) a[r] = 0.f;
                for (int k = ks * 32; k < ks * 32 + 32; ++k) { const float w = F.w_in[(size_t)k * NPROJ + col];
#pragma unroll
                    for (int r = 0; r < 16; ++r) a[r] += am[r * D + k] * w; }
#pragma unroll
                for (int r = 0; r < 16; ++r) red[(ks * 14 + c) * 16 + r] = a[r]; }
            __syncthreads();
            if (F.tid < 224) { const int c = F.tid / 16, r = F.tid % 16; float s = 0.f;
                for (int ks = 0; ks < 32; ++ks) s += red[(ks * 14 + c) * 16 + r];
                red[c * 16 + r] = s;
                const int col = cb * 14 + c; ((float*)(ws + WS_META))[r * NPROJ + col] = s;
                if (col >= 512 && col < 1024) { bf16* KM = (bf16*)(ws + WS_META + META_KM); const int d = col - 512; KM[frag_off(0, d >> 4, (d >> 3) & 1, r) + (d & 7)] = (bf16)f2bf(s); KM[frag_off(0, d >> 4, (d >> 3) & 1, 16 + r) + (d & 7)] = 0; }
                if (col >= 1024 && col < 1536) { bf16* VTM = (bf16*)(ws + WS_META + META_VTM); const int d = col - 1024, jj = (r & 3) + 4 * (r >> 3), hq = (r >> 2) & 1; VTM[vtf_off(d >> 5, 1, 0, 0, hq, d & 31) + jj] = (bf16)f2bf(s); VTM[vtf_off(d >> 5, 1, 0, 1, hq, d & 31) + jj] = 0; } }
            __syncthreads();
            if (F.tid < 14) { const int col = cb * 14 + F.tid;
                if (col >= 2048 && col < 2560) { const int d = col - 2048; const float la = F.lb_logits[d], lb2 = F.lb_logits[512 + d], mx = fmaxf(la, lb2), ea = __expf(la - mx), eb = __expf(lb2 - mx), lb = ea / (ea + eb);
                    float Gs[16], ks[16], G = 0.f;
#pragma unroll
                    for (int r = 0; r < 16; ++r) { const float xx = red[F.tid * 16 + r], sg = 1.0f / (1.0f + __expf(-xx)), f = lb + (1.f - lb) * sg; G += __logf(f); Gs[r] = G; ks[r] = (1.f - lb) * (1.f - sg); }
#pragma unroll
                    for (int r = 0; r < 16; ++r) ((float*)(ws + WS_META + META_MKH))[r * 512 + d] = ks[r] * __expf(G - Gs[r]); } }
            __syncthreads();
        }
    }
    if (F.bx == (1 % F.G)) { float* LB = (float*)(ws + WS_META + META_LB); const float a = F.lb_logits[F.tid], b = F.lb_logits[512 + F.tid], m = fmaxf(a, b), ea = __expf(a - m), eb = __expf(b - m); LB[F.tid] = ea / (ea + eb); }
    for (int i = F.bx * 512 + F.tid; i < 48 * D; i += F.G * 512) { const int e = i / D, k = i % D; float v = 0.f; if (e < 4) v = F.w_rg[k * 4 + e]; else if (e < 36) v = F.w_re[k * 32 + (e - 4)]; ((bf16*)(ws + WS_WRT))[i] = (bf16)f2bf(v * F.g_ffn[k]); }
    {
        LAS float* scr = (LAS float*)(F.lds + RING_OFF + F.wave * 16384);
        constexpr int I_IN = (D / 64) * (NPROJ / 32), I_OUT = (D / 64) * (D / 32), I_GU = NE * (D / 64) * (1024 / 32), I_DN = NE * (FF / 64) * (D / 32);
        constexpr int NITEMS = I_IN + I_OUT + I_GU + I_DN;
        for (int it = gw; it < NITEMS; it += NGW) {
            int r = it;
            if (r < I_IN) { const int nb = r % (NPROJ / 32), kb = r / (NPROJ / 32), r0 = 32 * nb; int src;
                if (r0 < 1024) src = r0; else if (r0 < 2048) { const int q = r0 - 1024, blk = q / 256, wi = q % 256; src = (wi >= 128 ? 2048 : 1536) + 128 * blk + (wi % 128); }
                else if (r0 < 2560) src = 3072 + (r0 - 2048); else if (r0 < 3072) src = 1024 + (r0 - 2560); else src = 2560 + (r0 - 3072);
                p0_transpose_item(F.w_in, NPROJ, src, 64 * kb, (bf16*)(ws + WS_WIN), D, 32 * nb, F.g_mix, scr, F.lane); continue; } r -= I_IN;
            if (r < I_OUT) { const int nb = r % (D / 32), kb = r / (D / 32); p0_transpose_item(F.w_out, D, 32 * nb, 64 * kb, (bf16*)(ws + WS_WOUT), D, 32 * nb, nullptr, scr, F.lane); continue; } r -= I_OUT;
            if (r < I_GU) { const int e = r / (16 * 32), q = r % (16 * 32), nb = q % 32, kb = q / 32, pn = nb / 8, half = (nb % 8) / 4, i0 = (nb % 4) * 32;
                const float* src = (half ? F.w_up : F.w_gate) + (size_t)e * D * FF;
                p0_transpose_item(src, FF, 128 * pn + i0, 64 * kb, (bf16*)(ws + WS_WGU) + (size_t)e * 1024 * D, D, 32 * nb, F.g_ffn, scr, F.lane); continue; } r -= I_GU;
            { const int e = r / (8 * 32), q = r % (8 * 32), nb = q % 32, kb = q / 32;
                p0_transpose_item(F.w_down + (size_t)e * FF * D, D, 32 * nb, 64 * kb, (bf16*)(ws + WS_WDN) + (size_t)e * D * FF, FF, 32 * nb, nullptr, scr, F.lane); }
        }
    }
    for (int m0 = gw * 4; m0 < NTOK; m0 += NGW * 4) {
        f32x4 v[4][4];
#pragma unroll
        for (int r = 0; r < 4; ++r) { const GAS f32x4* xr = (const GAS f32x4*)(F.x + (size_t)(m0 + r) * D) + F.lane;
#pragma unroll
            for (int j = 0; j < 4; ++j) v[r][j] = __builtin_nontemporal_load(xr + 64 * j); }
#pragma unroll
        for (int r = 0; r < 4; ++r) { float s = 0.f;
#pragma unroll
            for (int j = 0; j < 4; ++j) s += (v[r][j].x * v[r][j].x + v[r][j].y * v[r][j].y) + (v[r][j].z * v[r][j].z + v[r][j].w * v[r][j].w);
            s = wave_sum(s);
            if (F.lane == 0) ((float*)(ws + WS_RSTD1))[m0 + r] = 1.0f / sqrtf(s * (1.f / D) + EPS);
            GAS v2u* o8 = (GAS v2u*)((bf16*)(ws + WS_XB) + (size_t)(m0 + r) * D) + F.lane;
#pragma unroll
            for (int j = 0; j < 4; ++j) { v2u w; w.x = pk2(v[r][j].x, v[r][j].y); w.y = pk2(v[r][j].z, v[r][j].w); o8[64 * j] = w; } }
    }
}

struct EpiInProj {
    static constexpr bool PERM = true;
    const float* rstd; const float* LB; bf16* SQ; bf16* SK; bf16* QT; bf16* KT; bf16* KH; float* EGL; bf16* HGS;
    __device__ __forceinline__ void operator()(const pg8::f32x4 (&acc)[2][2][4][2], const pg8::Unit& u, int, int wr, int wc, int fr, int fq) const {
        const int row0 = u.pm * 256 + wr * 64 + fr, cl = wc * 32 + 8 * fq;
        if (u.pn >= 4 && u.pn < 8) {
            const int c0 = (u.pn - 4) * 128 + cl;
            const f32x4 lb0 = *(const f32x4*)(LB + c0), lb1 = *(const f32x4*)(LB + c0 + 4);
#pragma unroll
            for (int ai = 0; ai < 2; ++ai)
#pragma unroll
                for (int mp = 0; mp < 2; ++mp) {
                    const int rA = row0 + ai * 128 + mp * 32, rB = rA + 16; const float rsA = rstd[rA], rsB = rstd[rB];
                    float qt[2][8], kt[2][8], kh[2][8], egl[8];
#pragma unroll
                    for (int cc = 0; cc < 8; ++cc) {
                        const float lb = cc < 4 ? lb0[cc & 3] : lb1[cc & 3];
                        const float xq0 = acc[ai][0][2 * mp][cc >> 2][cc & 3] * rsA, xq1 = acc[ai][0][2 * mp + 1][cc >> 2][cc & 3] * rsB;
                        const float xf0 = acc[ai][1][2 * mp][cc >> 2][cc & 3] * rsA, xf1 = acc[ai][1][2 * mp + 1][cc >> 2][cc & 3] * rsB;
                        const float sg0 = __builtin_amdgcn_rcpf(1.f + __expf(-xf0)), sg1 = __builtin_amdgcn_rcpf(1.f + __expf(-xf1));
                        const float k0 = (1.f - lb) * (1.f - sg0), k1 = (1.f - lb) * (1.f - sg1);
                        float s0 = __logf(lb + (1.f - lb) * sg0), s1 = __logf(lb + (1.f - lb) * sg1);
#pragma unroll
                        for (int dd = 1; dd < 16; dd <<= 1) { const float y0 = __shfl_up(s0, dd, 16), y1 = __shfl_up(s1, dd, 16); if (fr >= dd) { s0 += y0; s1 += y1; } }
                        s1 += __shfl(s0, 15, 16);
                        const float GL = __shfl(s1, 15, 16);
                        qt[0][cc] = silu_f(xq0) * __expf(s0); qt[1][cc] = silu_f(xq1) * __expf(s1);
                        kt[0][cc] = k0 * __expf(-s0); kt[1][cc] = k1 * __expf(-s1);
                        kh[0][cc] = k0 * __expf(GL - s0); kh[1][cc] = k1 * __expf(GL - s1);
                        egl[cc] = __expf(GL);
                    }
#pragma unroll
                    for (int par = 0; par < 2; ++par) { const int rr = par ? rB : rA; const size_t p0 = frag_off(rr >> 5, c0 >> 4, 0, rr & 31) + 4 * ((c0 >> 3) & 1), p1 = p0 + 32 * 8; v2u w;
                        w.x = pg8::cvt_pk_bf16(qt[par][0], qt[par][1]); w.y = pg8::cvt_pk_bf16(qt[par][2], qt[par][3]); *(v2u*)(QT + p0) = w; w.x = pg8::cvt_pk_bf16(qt[par][4], qt[par][5]); w.y = pg8::cvt_pk_bf16(qt[par][6], qt[par][7]); *(v2u*)(QT + p1) = w;
                        w.x = pg8::cvt_pk_bf16(kt[par][0], kt[par][1]); w.y = pg8::cvt_pk_bf16(kt[par][2], kt[par][3]); *(v2u*)(KT + p0) = w; w.x = pg8::cvt_pk_bf16(kt[par][4], kt[par][5]); w.y = pg8::cvt_pk_bf16(kt[par][6], kt[par][7]); *(v2u*)(KT + p1) = w;
                        pg8::u32x4 w4; w4.x = pg8::cvt_pk_bf16(kh[par][0], kh[par][1]); w4.y = pg8::cvt_pk_bf16(kh[par][2], kh[par][3]); w4.z = pg8::cvt_pk_bf16(kh[par][4], kh[par][5]); w4.w = pg8::cvt_pk_bf16(kh[par][6], kh[par][7]);
                        *(pg8::u32x4*)(KH + frag_off(rr >> 5, c0 >> 4, (c0 >> 3) & 1, rr & 31)) = w4; }
                    if (fr == 15) { float* ep = EGL + (size_t)(rA >> 5) * 512 + c0; *(f32x4*)ep = (f32x4){egl[0], egl[1], egl[2], egl[3]}; *(f32x4*)(ep + 4) = (f32x4){egl[4], egl[5], egl[6], egl[7]}; }
                }
            return;
        }
        const int kind = u.pn < 2 ? 0 : (u.pn < 4 ? 1 : 2);
#pragma unroll
        for (int ai = 0; ai < 2; ++ai)
#pragma unroll
            for (int m = 0; m < 4; ++m) {
                const int row = row0 + ai * 128 + m * 16; const float rs = rstd[row];
#pragma unroll
                for (int bj = 0; bj < 2; ++bj) {
                    f32x4 v0 = acc[ai][bj][m][0] * rs, v1 = acc[ai][bj][m][1] * rs;
                    if (kind == 0) { v0 = v0 * QSCALE; v1 = v1 * QSCALE; }
                    if (kind == 2) {
#pragma unroll
                        for (int j = 0; j < 4; ++j) { v0[j] = silu_f(v0[j]); v1[j] = silu_f(v1[j]); } }
                    pg8::u32x4 w; w.x = pg8::cvt_pk_bf16(v0[0], v0[1]); w.y = pg8::cvt_pk_bf16(v0[2], v0[3]); w.z = pg8::cvt_pk_bf16(v1[0], v1[1]); w.w = pg8::cvt_pk_bf16(v1[2], v1[3]);
                    if (u.pn < 4) { const int c8 = (u.pn & 1) * 256 + bj * 128 + cl; *(pg8::u32x4*)((u.pn < 2 ? SQ : SK) + frag_off(row >> 5, c8 >> 4, (c8 >> 3) & 1, row & 31)) = w; }
                    else *(pg8::u32x4*)(HGS + (size_t)row * 512 + (u.pn - 8) * 256 + bj * 128 + cl) = w;
                }
            }
    }
};
struct EpiVT {
    static constexpr bool PERM = true;
    const float* rstd; bf16* VT;
    __device__ __forceinline__ void operator()(const pg8::f32x4 (&acc)[2][2][4][2], const pg8::Unit& u, int, int wr, int wc, int fr, int fq) const {
        const int row0 = u.pm * 256 + wr * 64 + fr, col0 = u.pn * 256 + wc * 32 + 8 * fq;
        f32x4 rsv[2][2];
#pragma unroll
        for (int bj = 0; bj < 2; ++bj)
#pragma unroll
            for (int n = 0; n < 2; ++n) rsv[bj][n] = *(const f32x4*)(rstd + col0 + bj * 128 + 4 * n);
#pragma unroll
        for (int ai = 0; ai < 2; ++ai)
#pragma unroll
            for (int m = 0; m < 4; ++m) {
                const int wrow = row0 + ai * 128 + m * 16;
#pragma unroll
                for (int bj = 0; bj < 2; ++bj) { const f32x4 v0 = acc[ai][bj][m][0] * rsv[bj][0], v1 = acc[ai][bj][m][1] * rsv[bj][1];
                    const int t0 = col0 + bj * 128; const size_t p0 = vtf_off(wrow >> 5, NTOK / 32, t0 >> 5, (t0 >> 4) & 1, 0, wrow & 31) + 4 * ((t0 >> 3) & 1);
                    v2u w; w.x = pg8::cvt_pk_bf16(v0[0], v0[1]); w.y = pg8::cvt_pk_bf16(v0[2], v0[3]); *(v2u*)(VT + p0) = w;
                    w.x = pg8::cvt_pk_bf16(v1[0], v1[1]); w.y = pg8::cvt_pk_bf16(v1[2], v1[3]); *(v2u*)(VT + p0 + 32 * 8) = w; }
            }
    }
};
struct EpiOutProj {
    static constexpr bool PERM = true;
    const float* x; float* H; bf16* HB16;
    __device__ __forceinline__ void operator()(const pg8::f32x4 (&acc)[2][2][4][2], const pg8::Unit& u, int, int wr, int wc, int fr, int fq) const {
        const int row0 = u.pm * 256 + wr * 64 + fr, col0 = u.pn * 256 + wc * 32 + 8 * fq;
#pragma unroll
        for (int ai = 0; ai < 2; ++ai)
#pragma unroll
            for (int m = 0; m < 4; ++m) {
                const size_t ro = (size_t)(row0 + ai * 128 + m * 16) * D + col0;
#pragma unroll
                for (int bj = 0; bj < 2; ++bj) {
                    const size_t off = ro + bj * 128;
                    const f32x4 v0 = acc[ai][bj][m][0] + *(const f32x4*)(x + off), v1 = acc[ai][bj][m][1] + *(const f32x4*)(x + off + 4);
                    *(f32x4*)(H + off) = v0; *(f32x4*)(H + off + 4) = v1;
                    pg8::u32x4 w; w.x = pg8::cvt_pk_bf16(v0[0], v0[1]); w.y = pg8::cvt_pk_bf16(v0[2], v0[3]); w.z = pg8::cvt_pk_bf16(v1[0], v1[1]); w.w = pg8::cvt_pk_bf16(v1[2], v1[3]);
                    *(pg8::u32x4*)(HB16 + off) = w;
                }
            }
    }
};
struct EpiGateUp {
    static constexpr bool PERM = true;
    const LAS float* lrstd; bf16* HBUF;
    __device__ __forceinline__ void operator()(const pg8::f32x4 (&acc)[2][2][4][2], const pg8::Unit& u, int ord, int wr, int wc, int fr, int fq) const {
        const int rl0 = wr * 64 + fr, col0 = u.pn * 128 + wc * 32 + 8 * fq;
#pragma unroll
        for (int ai = 0; ai < 2; ++ai)
#pragma unroll
            for (int m = 0; m < 4; ++m) {
                const int rl = rl0 + ai * 128 + m * 16; const float rs = lrstd[ord * 256 + rl];
                const f32x4 g0 = acc[ai][0][m][0] * rs, g1 = acc[ai][0][m][1] * rs, u0 = acc[ai][1][m][0] * rs, u1 = acc[ai][1][m][1] * rs;
                float h[8];
#pragma unroll
                for (int j = 0; j < 4; ++j) { h[j] = silu_f(g0[j]) * u0[j]; h[4 + j] = silu_f(g1[j]) * u1[j]; }
                pg8::u32x4 w; w.x = pg8::cvt_pk_bf16(h[0], h[1]); w.y = pg8::cvt_pk_bf16(h[2], h[3]); w.z = pg8::cvt_pk_bf16(h[4], h[5]); w.w = pg8::cvt_pk_bf16(h[6], h[7]);
                *(pg8::u32x4*)(HBUF + (size_t)(u.pm * 256 + rl) * FF + col0) = w;
            }
    }
};
struct EpiDown {
    static constexpr bool PERM = true;
    const LAS unsigned* ltok; const LAS float* lgate; bf16* Y0; bf16* Y1;
    __device__ __forceinline__ void operator()(const pg8::f32x4 (&acc)[2][2][4][2], const pg8::Unit& u, int ord, int wr, int wc, int fr, int fq) const {
        const int rl0 = wr * 64 + fr, col0 = u.pn * 256 + wc * 32 + 8 * fq;
#pragma unroll
        for (int ai = 0; ai < 2; ++ai)
#pragma unroll
            for (int m = 0; m < 4; ++m) {
                const int rl = rl0 + ai * 128 + m * 16; const unsigned tp = ltok[ord * 256 + rl]; const float gt = lgate[ord * 256 + rl];
                if (!(tp & 0x80000000u)) {
                    bf16* yb = ((tp >> 30) & 1u) ? Y1 : Y0; const size_t ro = (size_t)(tp & 0xffffu) * D + col0;
#pragma unroll
                    for (int bj = 0; bj < 2; ++bj) { const f32x4 v0 = acc[ai][bj][m][0] * gt, v1 = acc[ai][bj][m][1] * gt;
                        pg8::u32x4 w; w.x = pg8::cvt_pk_bf16(v0[0], v0[1]); w.y = pg8::cvt_pk_bf16(v0[2], v0[3]); w.z = pg8::cvt_pk_bf16(v1[0], v1[1]); w.w = pg8::cvt_pk_bf16(v1[2], v1[3]);
                        *(pg8::u32x4*)(yb + ro + bj * 128) = w; }
                }
            }
    }
};
template <bool GATHER> struct MoeOrder {
    const LAS int* tstart; const LAS int* cntl; const LAS unsigned* ltok; const char* A; const char* Bt; int K, G, c, nunits;
    __device__ bool next(int i, pg8::Unit& u) const {
        const int L = i * G + c; if (L >= nunits) return false;
        const int rt = L >> 2; int e = 0;
        while (e < NE - 1 && tstart[e + 1] <= rt) ++e;
        e = __builtin_amdgcn_readfirstlane(e);
        u.pm = rt; u.pn = L & 3; u.e = e; const int left = cntl[e] - (rt - tstart[e]) * 256; u.rows = __builtin_amdgcn_readfirstlane(left < 256 ? left : 256); return true;
    }
    __device__ __forceinline__ const char* a_base(const pg8::Unit& u) const { return GATHER ? A : A + (size_t)u.pm * 256 * K * 2; }
    __device__ __forceinline__ const char* b_base(const pg8::Unit& u) const { return Bt + ((size_t)u.e * 1024 + (size_t)u.pn * 256) * K * 2; }
    __device__ __forceinline__ void a_off(const pg8::Unit&, int ord, const int (&sR)[2], const int (&sC)[2], unsigned (&g)[2][2]) const {
#pragma unroll
        for (int h = 0; h < 2; ++h)
#pragma unroll
            for (int i = 0; i < 2; ++i) {
                if (GATHER) g[h][i] = ((ltok[ord * 256 + h * 128 + sR[i]] & 0xffffu) * (unsigned)K + (unsigned)sC[i]) * 2u;
                else g[h][i] = (unsigned)((h * 128 + sR[i]) * K + sC[i]) * 2u;
            }
    }
};
__device__ __forceinline__ int moe_setup(Frame& F, int which  ) {
    volatile LAS int* M = (volatile LAS int*)F.MISC;
    if (F.tid < NE) M[40 + F.tid] = (int)__hip_atomic_load(F.ctl + CW_CNT + 64 * F.tid, RLX_AGENT);
    __syncthreads();
    if (F.tid == 0) { int s = 0; for (int e = 0; e < NE; ++e) { M[e] = s; s += (M[40 + e] + 255) >> 8; } M[NE] = s; }
    __syncthreads();
    const int nrt = M[NE], nunits = nrt * 4;
    LAS unsigned* ltok = (LAS unsigned*)(F.lds + LIST_OFF); LAS float* lval = (LAS float*)(F.lds + LIST_OFF + 8192);
    const unsigned* LT = (const unsigned*)(F.ws + WS_LTOK); const float* LV = (const float*)(F.ws + (which ? WS_LGATE : WS_LRSTD));
    for (int i = 0; i < 8; ++i) {
        const int L = i * F.G + F.bx; if (L >= nunits) break;
        const int rt = L >> 2; int e = 0; while (e < NE - 1 && M[e + 1] <= rt) ++e;
        if (F.tid < 256) { const int idx = (rt - M[e]) * 256 + F.tid; const bool ok = idx < M[40 + e];
            ltok[i * 256 + F.tid] = ok ? LT[(size_t)e * LCAP + idx] : 0x80000000u; lval[i * 256 + F.tid] = ok ? LV[(size_t)e * LCAP + idx] : 0.f; }
    }
    __syncthreads();
    return nunits;
}

typedef float f32x16 __attribute__((ext_vector_type(16)));
__device__ __forceinline__ void p2_attention(Frame& F) {
    const bf16* SQ = (const bf16*)(F.ws + WS_SQ); const bf16* SK = (const bf16*)(F.ws + WS_SK); const bf16* VT = (const bf16*)(F.ws + WS_VT);
    const bf16* KM = (const bf16*)(F.ws + WS_META + META_KM); const bf16* VTM = (const bf16*)(F.ws + WS_META + META_VTM); bf16* MIX = (bf16*)(F.ws + WS_MIXED);
    const int c = F.lane & 31, hh = F.lane >> 5;
    const int gw = F.bx * NWAVES + F.wave, NGW = F.G * NWAVES;
    for (int item = gw; item < NB * SBH * (SEQ / 32); item += NGW) {
        const int qb = item & 127, h = (item >> 7) & 7, b = item >> 10;
        const size_t tok0 = (size_t)b * SEQ;
        bf16x8 qf[4];
        const int ch0 = (int)(tok0 >> 5);
#pragma unroll
        for (int ks = 0; ks < 4; ++ks) qf[ks] = *(const bf16x8*)(SQ + frag_off(ch0 + qb, h * 4 + ks, hh, c));
        f32x16 o0, o1;
#pragma unroll
        for (int i = 0; i < 16; ++i) { o0[i] = 0.f; o1[i] = 0.f; }
        float R = 0.f;
        for (int kt = qb; kt >= -1; --kt) {
            const bf16* kp = kt >= 0 ? SK + frag_off(ch0 + kt, h * 4, hh, c) : KM + frag_off(0, h * 4, hh, c);
            const bf16* vp = kt >= 0 ? VT + vtf_off(2 * h, NTOK / 32, ch0 + kt, 0, hh, c) : VTM + vtf_off(2 * h, 1, 0, 0, hh, c);
            const size_t vblk = kt >= 0 ? (size_t)(NTOK / 32) * 1024 : (size_t)1024;
            bf16x8 kf[4];
#pragma unroll
            for (int ks = 0; ks < 4; ++ks) kf[ks] = *(const bf16x8*)(kp + ks * 512);
            bf16x8 vfr[2][2];
#pragma unroll
            for (int bl = 0; bl < 2; ++bl)
#pragma unroll
                for (int sx = 0; sx < 2; ++sx) vfr[bl][sx] = *(const bf16x8*)(vp + bl * vblk + sx * 512);
            f32x16 st;
#pragma unroll
            for (int i = 0; i < 16; ++i) st[i] = 0.f;
#pragma unroll
            for (int ks = 0; ks < 4; ++ks) st = __builtin_amdgcn_mfma_f32_32x32x16_bf16(kf[ks], qf[ks], st, 0, 0, 0);
            const bool diag = (kt == qb), meta = (kt < 0);
            float lk[16], lbt[16]; bool ok[16];
#pragma unroll
            for (int r = 0; r < 16; ++r) { const int kk = (r & 3) + 8 * (r >> 2) + 4 * hh; const float z = st[r];
                const float L = __builtin_amdgcn_logf(1.0f + __builtin_amdgcn_exp2f(-fabsf(z)));
                ok[r] = diag ? (kk < c) : (meta ? (kk < NMETA) : true);
                lk[r] = ok[r] ? -(fmaxf(z, 0.f) + L) : 0.f; lbt[r] = fminf(z, 0.f) - L; }
            float sg[4], pp[4], tot[4];
#pragma unroll
            for (int g = 0; g < 4; ++g) { sg[g] = (lk[4 * g] + lk[4 * g + 1]) + (lk[4 * g + 2] + lk[4 * g + 3]); pp[g] = __shfl_xor(sg[g], 32); tot[g] = sg[g] + pp[g]; }
            float lat[4]; lat[3] = 0.f; lat[2] = tot[3]; lat[1] = tot[3] + tot[2]; lat[0] = lat[1] + tot[1];
            float w[16];
#pragma unroll
            for (int g = 0; g < 4; ++g) { const float base = R + lat[g] + (hh == 0 ? pp[g] : 0.f);
                const float t3 = base, t2 = t3 + lk[4 * g + 3], t1 = t2 + lk[4 * g + 2], t0 = t1 + lk[4 * g + 1];
                w[4 * g + 3] = ok[4 * g + 3] ? __builtin_amdgcn_exp2f(lbt[4 * g + 3] + t3) : 0.f; w[4 * g + 2] = ok[4 * g + 2] ? __builtin_amdgcn_exp2f(lbt[4 * g + 2] + t2) : 0.f;
                w[4 * g + 1] = ok[4 * g + 1] ? __builtin_amdgcn_exp2f(lbt[4 * g + 1] + t1) : 0.f; w[4 * g + 0] = ok[4 * g + 0] ? __builtin_amdgcn_exp2f(lbt[4 * g + 0] + t0) : 0.f; }
            R += lat[0] + tot[0];
#pragma unroll
            for (int sx = 0; sx < 2; ++sx) {
                v4u wu; wu.x = pg8::cvt_pk_bf16(w[8 * sx + 0], w[8 * sx + 1]); wu.y = pg8::cvt_pk_bf16(w[8 * sx + 2], w[8 * sx + 3]); wu.z = pg8::cvt_pk_bf16(w[8 * sx + 4], w[8 * sx + 5]); wu.w = pg8::cvt_pk_bf16(w[8 * sx + 6], w[8 * sx + 7]);
                const bf16x8 wf = __builtin_bit_cast(bf16x8, wu);
                o0 = __builtin_amdgcn_mfma_f32_32x32x16_bf16(vfr[0][sx], wf, o0, 0, 0, 0);
                o1 = __builtin_amdgcn_mfma_f32_32x32x16_bf16(vfr[1][sx], wf, o1, 0, 0, 0);
            }
            if (__all(R < -160.f)) break;
        }
        float ss = 0.f;
#pragma unroll
        for (int i = 0; i < 16; ++i) ss += o0[i] * o0[i] + o1[i] * o1[i];
        ss += __shfl_xor(ss, 32);
        const float rs = 1.0f / sqrtf(ss * (1.f / 64.f) + EPS);
        bf16* op = MIX + (tok0 + 32 * qb + c) * D + h * 64 + 4 * hh;
#pragma unroll
        for (int g = 0; g < 4; ++g) {
            const f32x4 g0 = *(const f32x4*)(F.sb_gain + h * 64 + 8 * g + 4 * hh), g1 = *(const f32x4*)(F.sb_gain + h * 64 + 32 + 8 * g + 4 * hh);
            v2u w0, w1; w0.x = pg8::cvt_pk_bf16(o0[4 * g] * rs * g0.x, o0[4 * g + 1] * rs * g0.y); w0.y = pg8::cvt_pk_bf16(o0[4 * g + 2] * rs * g0.z, o0[4 * g + 3] * rs * g0.w);
            w1.x = pg8::cvt_pk_bf16(o1[4 * g] * rs * g1.x, o1[4 * g + 1] * rs * g1.y); w1.y = pg8::cvt_pk_bf16(o1[4 * g + 2] * rs * g1.z, o1[4 * g + 3] * rs * g1.w);
            *(v2u*)(op + 8 * g) = w0; *(v2u*)(op + 32 + 8 * g) = w1;
        }
    }
}
template <int B0> __device__ __forceinline__ bf16x8 cvt8(const f32x16& x) {
    v4u a; a.x = pg8::cvt_pk_bf16(x[B0 + 0], x[B0 + 1]); a.y = pg8::cvt_pk_bf16(x[B0 + 2], x[B0 + 3]); a.z = pg8::cvt_pk_bf16(x[B0 + 4], x[B0 + 5]); a.w = pg8::cvt_pk_bf16(x[B0 + 6], x[B0 + 7]); return __builtin_bit_cast(bf16x8, a); }
__device__ __forceinline__ bf16x8 mk8(const bf16* p) { const v2u lo = *(const v2u*)p, hi = *(const v2u*)(p + 8); v4u a; a.x = lo.x; a.y = lo.y; a.z = hi.x; a.w = hi.y; return __builtin_bit_cast(bf16x8, a); }
__device__ __forceinline__ void hgrn_update(f32x16 (&S)[4], const bf16* khp  , const float* eglp, const bf16x8 (&idf)[2], const bf16x8 (&vf)[2]) {
#pragma unroll
    for (int i = 0; i < 4; ++i) {
#pragma unroll
        for (int g = 0; g < 4; ++g) { const f32x4 d = *(const f32x4*)(eglp + 32 * i + 8 * g); S[i][4 * g] *= d.x; S[i][4 * g + 1] *= d.y; S[i][4 * g + 2] *= d.z; S[i][4 * g + 3] *= d.w; }
        const bf16x8 a0 = *(const bf16x8*)(khp + (2 * i) * 512), a1 = *(const bf16x8*)(khp + (2 * i + 1) * 512);
        f32x16 X;
#pragma unroll
        for (int r = 0; r < 16; ++r) X[r] = 0.f;
        X = __builtin_amdgcn_mfma_f32_32x32x16_bf16(a0, idf[0], X, 0, 0, 0); X = __builtin_amdgcn_mfma_f32_32x32x16_bf16(a1, idf[1], X, 0, 0, 0);
        S[i] = __builtin_amdgcn_mfma_f32_32x32x16_bf16(cvt8<0>(X), vf[0], S[i], 0, 0, 0); S[i] = __builtin_amdgcn_mfma_f32_32x32x16_bf16(cvt8<8>(X), vf[1], S[i], 0, 0, 0);
    }
}
template <bool OUT> __device__ __forceinline__ void p2_hgrn(Frame& F) {
    const bf16* QT = (const bf16*)(F.ws + WS_QT); const bf16* KT = (const bf16*)(F.ws + WS_KT); const bf16* KH = (const bf16*)(F.ws + WS_KH); const bf16* VT = (const bf16*)(F.ws + WS_VT);
    const bf16* HGS = (const bf16*)(F.ws + WS_HGS); const float* EGL = (const float*)(F.ws + WS_EGL); float* SST = (float*)(F.ws + WS_SST); bf16* MIX = (bf16*)(F.ws + WS_MIXED);
    const int c = F.lane & 31, hh = F.lane >> 5, slot = F.wave >> 2, dvb = F.wave & 3;
    LAS float* red = (LAS float*)(F.lds);
    bf16x8 idf[2];
#pragma unroll
    for (int st = 0; st < 2; ++st) { v4u a; a.x = a.y = a.z = a.w = 0u; const int j = c - 16 * st - 8 * hh;
        if (j >= 0 && j < 8) { const unsigned one = (j & 1) ? 0x3F800000u : 0x00003F80u; if ((j >> 1) == 0) a.x = one; else if ((j >> 1) == 1) a.y = one; else if ((j >> 1) == 2) a.z = one; else a.w = one; }
        idf[st] = __builtin_bit_cast(bf16x8, a); }
    for (int ub = F.bx * 2; ub < NB * HGH * 16; ub += F.G * 2) {
        const int u = ub + slot, b = u >> 6, h = (u >> 4) & 3, jc = u & 15;
        const size_t tok0 = (size_t)b * SEQ + 256 * jc;
        float* sst = SST + ((size_t)(u * 4 + dvb) * 16) * 256 + F.lane * 4;
        f32x16 S[4];
        if (OUT) {
#pragma unroll
            for (int i = 0; i < 4; ++i)
#pragma unroll
                for (int g = 0; g < 4; ++g) { const f32x4 v = *(const f32x4*)(sst + (i * 4 + g) * 256); S[i][4 * g] = v.x; S[i][4 * g + 1] = v.y; S[i][4 * g + 2] = v.z; S[i][4 * g + 3] = v.w; }
        } else {
#pragma unroll
            for (int i = 0; i < 4; ++i)
#pragma unroll
                for (int r = 0; r < 16; ++r) S[i][r] = 0.f;
        }
        const int ch0 = (int)(tok0 >> 5);
        for (int cs = 0; cs < 8; ++cs) {
            const size_t tokc = tok0 + 32 * cs;
            const bf16* vp = VT + vtf_off(16 + 4 * h + dvb, NTOK / 32, ch0 + cs, 0, hh, c);
            bf16x8 vf[2]; vf[0] = *(const bf16x8*)vp; vf[1] = *(const bf16x8*)(vp + 512);
            const bf16* khp = KH + frag_off(ch0 + cs, h * 8, hh, c); const float* eglp = EGL + (tokc >> 5) * 512 + h * 128 + 4 * hh;
            if (OUT) {
                const bf16* qp = QT + frag_off(ch0 + cs, h * 8, hh, c); const bf16* kp = KT + frag_off(ch0 + cs, h * 8, hh, c);
                bf16x8 qf[8];
#pragma unroll
                for (int ks = 0; ks < 8; ++ks) qf[ks] = *(const bf16x8*)(qp + ks * 512);
                f32x16 P;
#pragma unroll
                for (int r = 0; r < 16; ++r) P[r] = 0.f;
#pragma unroll
                for (int ks = 0; ks < 8; ++ks) P = __builtin_amdgcn_mfma_f32_32x32x16_bf16(*(const bf16x8*)(kp + ks * 512), qf[ks], P, 0, 0, 0);
#pragma unroll
                for (int r = 0; r < 16; ++r) { const int srow = (r & 3) + 8 * (r >> 2) + 4 * hh; P[r] = (srow <= c) ? P[r] : 0.f; }
                f32x16 O;
#pragma unroll
                for (int r = 0; r < 16; ++r) O[r] = 0.f;
                O = __builtin_amdgcn_mfma_f32_32x32x16_bf16(vf[0], cvt8<0>(P), O, 0, 0, 0); O = __builtin_amdgcn_mfma_f32_32x32x16_bf16(vf[1], cvt8<8>(P), O, 0, 0, 0);
#pragma unroll
                for (int i = 0; i < 4; ++i) { O = __builtin_amdgcn_mfma_f32_32x32x16_bf16(cvt8<0>(S[i]), qf[2 * i], O, 0, 0, 0); O = __builtin_amdgcn_mfma_f32_32x32x16_bf16(cvt8<8>(S[i]), qf[2 * i + 1], O, 0, 0, 0); }
                float ss = 0.f;
#pragma unroll
                for (int r = 0; r < 16; ++r) ss += O[r] * O[r];
                ss += __shfl_xor(ss, 32);
                LAS float* rp = red + ((slot * 2 + (cs & 1)) * 4) * 32;
                if (hh == 0) rp[dvb * 32 + c] = ss;
                __syncthreads();
                const float tot = (rp[c] + rp[32 + c]) + (rp[64 + c] + rp[96 + c]);
                const float rs = 1.0f / sqrtf(tot * (1.f / 128.f) + EPS);
                const int dcol = h * 128 + 32 * dvb + 4 * hh;
                const bf16* gp = HGS + (tokc + c) * 512 + dcol; bf16* op = MIX + (tokc + c) * D + 512 + dcol;
#pragma unroll
                for (int g = 0; g < 4; ++g) { const v2u gs = *(const v2u*)(gp + 8 * g); const f32x4 gn = *(const f32x4*)(F.hg_gain + dcol + 8 * g);
                    v2u w; w.x = pg8::cvt_pk_bf16(O[4 * g] * rs * gn.x * bflo(gs.x), O[4 * g + 1] * rs * gn.y * bfhi(gs.x)); w.y = pg8::cvt_pk_bf16(O[4 * g + 2] * rs * gn.z * bflo(gs.y), O[4 * g + 3] * rs * gn.w * bfhi(gs.y));
                    *(v2u*)(op + 8 * g) = w; }
            }
            hgrn_update(S, khp, eglp, idf, vf);
        }
        if (!OUT) {
#pragma unroll
            for (int i = 0; i < 4; ++i)
#pragma unroll
                for (int g = 0; g < 4; ++g) *(f32x4*)(sst + (i * 4 + g) * 256) = (f32x4){S[i][4 * g], S[i][4 * g + 1], S[i][4 * g + 2], S[i][4 * g + 3]};
        }
    }
}
__device__ __forceinline__ void p2_hgrn_scan(Frame& F) {
    float* SST = (float*)(F.ws + WS_SST); const float* EGL = (const float*)(F.ws + WS_EGL); const float* MKH = (const float*)(F.ws + WS_META + META_MKH); const float* MP = (const float*)(F.ws + WS_META);
    for (int id = F.bx * 512 + F.tid; id < NB * HGH * 4096; id += F.G * 512) {
        const int bh = id >> 12, e4 = id & 4095, b = bh >> 2, h = bh & 3;
        const int ln = e4 & 63, g = (e4 >> 6) & 3, i = (e4 >> 8) & 3, dvb = e4 >> 10;
        const int dk = h * 128 + 32 * i + 8 * g + 4 * (ln >> 5), dv = h * 128 + 32 * dvb + (ln & 31);
        f32x4 s = (f32x4){0.f, 0.f, 0.f, 0.f};
        for (int r = 0; r < NMETA; ++r) { const f32x4 kk = *(const f32x4*)(MKH + r * 512 + dk); const float v = MP[(size_t)r * NPROJ + 2560 + dv]; s += kk * v; }
        for (int j = 0; j < 16; ++j) {
            float* p = SST + ((size_t)(bh * 16 + j) * 16384) + e4 * 4;
            const f32x4 loc = *(const f32x4*)p; *(f32x4*)p = s;
            f32x4 dt = (f32x4){1.f, 1.f, 1.f, 1.f};
#pragma unroll
            for (int cs = 0; cs < 8; ++cs) dt *= *(const f32x4*)(EGL + (size_t)(b * 128 + 8 * j + cs) * 512 + dk);
            s = dt * s + loc;
        }
    }
}
__device__ __forceinline__ void p4_router(Frame& F) {
    const bf16* HB = (const bf16*)(F.ws + WS_HB16); const bf16* WRT = (const bf16*)(F.ws + WS_WRT);
    unsigned* LT = (unsigned*)(F.ws + WS_LTOK); float* LGt = (float*)(F.ws + WS_LGATE); float* LRs = (float*)(F.ws + WS_LRSTD);
    LAS float* lg = (LAS float*)(F.lds) + F.wave * (16 * 48 + 16);
    volatile LAS int* M = (volatile LAS int*)F.MISC;
    const int fr = F.lane & 15, fq = F.lane >> 4;
    for (int tile = F.bx; tile < NTOK / 128; tile += F.G) {
        if (F.tid < NE) M[80 + F.tid] = 0;
        __syncthreads();
        const int row0 = tile * 128 + F.wave * 16;
        pg8::f32x4 acc[3]; acc[0] = acc[1] = acc[2] = (pg8::f32x4){0.f, 0.f, 0.f, 0.f}; float ss = 0.f;
        const bf16* ap = HB + (size_t)(row0 + fr) * D + 8 * fq; const bf16* bp = WRT + (size_t)fr * D + 8 * fq;
#pragma unroll 4
        for (int ks = 0; ks < 32; ++ks) {
            const bf16x8 a = *(const bf16x8*)(ap + 32 * ks);
            const v4u au = __builtin_bit_cast(v4u, a);
            ss += bflo(au.x) * bflo(au.x) + bfhi(au.x) * bfhi(au.x) + bflo(au.y) * bflo(au.y) + bfhi(au.y) * bfhi(au.y) + bflo(au.z) * bflo(au.z) + bfhi(au.z) * bfhi(au.z) + bflo(au.w) * bflo(au.w) + bfhi(au.w) * bfhi(au.w);
#pragma unroll
            for (int nt = 0; nt < 3; ++nt) { const bf16x8 bb = *(const bf16x8*)(bp + (size_t)nt * 16 * D + 32 * ks); acc[nt] = __builtin_amdgcn_mfma_f32_16x16x32_bf16(a, bb, acc[nt], 0, 0, 0); }
        }
        ss += __shfl_xor(ss, 16); ss += __shfl_xor(ss, 32);
#pragma unroll
        for (int nt = 0; nt < 3; ++nt)
#pragma unroll
            for (int j = 0; j < 4; ++j) lg[(fq * 4 + j) * 48 + nt * 16 + fr] = acc[nt][j];
        if (fq == 0) lg[16 * 48 + fr] = ss;
        __syncthreads();
        int e1 = 0, e2 = 0, r1 = 0, r2 = 0; float g1 = 0.f, g2 = 0.f, rstd = 0.f;
        if (F.lane < 16) {
            rstd = 1.0f / sqrtf(lg[16 * 48 + F.lane] * (1.f / D) + EPS);
            const LAS float* l = lg + F.lane * 48;
            float gl[4]; int gi = 0;
#pragma unroll
            for (int i = 0; i < 4; ++i) gl[i] = l[i] * rstd + F.b_rg[i];
#pragma unroll
            for (int i = 1; i < 4; ++i) if (gl[i] > gl[gi]) gi = i;
            float den = 0.f;
#pragma unroll
            for (int i = 0; i < 4; ++i) den += __expf(gl[i] - gl[gi]);
            const float pg = 1.0f / den;
            float v1 = -3.0e38f, v2 = -3.0e38f; int i1 = 0, i2 = 0;
            for (int i = 0; i < 8; ++i) { const float v = l[4 + gi * 8 + i] * rstd + F.b_re[gi * 8 + i]; if (v > v1) { v2 = v1; i2 = i1; v1 = v; i1 = i; } else if (v > v2) { v2 = v; i2 = i; } }
            const float ex = __expf(v2 - v1); g1 = pg / (1.f + ex); g2 = pg * ex / (1.f + ex);
            e1 = gi * 8 + i1; e2 = gi * 8 + i2;
            r1 = __hip_atomic_fetch_add((LAS int*)&M[80 + e1], 1, __ATOMIC_RELAXED, __HIP_MEMORY_SCOPE_WORKGROUP); r2 = __hip_atomic_fetch_add((LAS int*)&M[80 + e2], 1, __ATOMIC_RELAXED, __HIP_MEMORY_SCOPE_WORKGROUP);
        }
        __syncthreads();
        if (F.tid < NE) { const int n = M[80 + F.tid]; M[120 + F.tid] = n ? (int)__hip_atomic_fetch_add(F.ctl + CW_CNT + 64 * F.tid, (unsigned)n, RLX_AGENT) : 0; }
        __syncthreads();
        if (F.lane < 16) { const unsigned tok = (unsigned)(row0 + F.lane);
            const size_t p1 = (size_t)e1 * LCAP + M[120 + e1] + r1, p2 = (size_t)e2 * LCAP + M[120 + e2] + r2;
            LT[p1] = tok; LGt[p1] = g1; LRs[p1] = rstd; LT[p2] = tok | 0x40000000u; LGt[p2] = g2; LRs[p2] = rstd; }
        __syncthreads();
    }
}
__device__ __forceinline__ void p7_final(Frame& F) {
    const float* H = (const float*)(F.ws + WS_H); const bf16* Y0 = (const bf16*)(F.ws + WS_Y0); const bf16* Y1 = (const bf16*)(F.ws + WS_Y1);
    const int gw = F.bx * NWAVES + F.wave, NGW = F.G * NWAVES;
    f32x4 gf[4];
#pragma unroll
    for (int j = 0; j < 4; ++j) gf[j] = *(const f32x4*)(F.g_final + 4 * F.lane + 256 * j);
    for (int m = gw; m < NTOK; m += NGW) {
        const GAS f32x4* hr = (const GAS f32x4*)(H + (size_t)m * D) + F.lane; const GAS v2u* y0 = (const GAS v2u*)(Y0 + (size_t)m * D) + F.lane; const GAS v2u* y1 = (const GAS v2u*)(Y1 + (size_t)m * D) + F.lane;
        f32x4 v[4]; float s = 0.f;
#pragma unroll
        for (int j = 0; j < 4; ++j) { v[j] = hr[64 * j]; const v2u a = y0[64 * j], b = y1[64 * j];
            v[j].x += bflo(a.x) + bflo(b.x); v[j].y += bfhi(a.x) + bfhi(b.x); v[j].z += bflo(a.y) + bflo(b.y); v[j].w += bfhi(a.y) + bfhi(b.y);
            s += (v[j].x * v[j].x + v[j].y * v[j].y) + (v[j].z * v[j].z + v[j].w * v[j].w); }
        const float rstd = 1.0f / sqrtf(wave_sum(s) * (1.f / D) + EPS);
        GAS f32x4* o = (GAS f32x4*)(F.out + (size_t)m * D) + F.lane;
#pragma unroll
        for (int j = 0; j < 4; ++j) o[64 * j] = v[j] * rstd * gf[j];
    }
}

constexpr int NPHASES = 10;
__global__ void __launch_bounds__(NWAVES * 64, 2) hymba_fwd(Args args) {
    extern __shared__ __attribute__((aligned(16))) unsigned char lds[];
    Frame F;
    F.lds = (LAS unsigned char*)lds; F.MISC = (volatile LAS unsigned*)(F.lds + MISC_OFF);
    F.tid = threadIdx.x; F.lane = F.tid & 63; F.wave = __builtin_amdgcn_readfirstlane(F.tid >> 6); F.G = gridDim.x; F.bx = blockIdx.x;
    F.ws = args.ws; F.ctl = (gu32*)(args.ws + WS_CTL); F.out = args.out;
    F.x = args.in[0]; F.meta = args.in[1]; F.lb_logits = args.in[2]; F.g_mix = args.in[3]; F.w_in = args.in[4]; F.sb_gain = args.in[5]; F.hg_gain = args.in[6]; F.w_out = args.in[7]; F.g_ffn = args.in[8];
    F.w_rg = args.in[9]; F.b_rg = args.in[10]; F.w_re = args.in[11]; F.b_re = args.in[12]; F.w_gate = args.in[13]; F.w_up = args.in[14]; F.w_down = args.in[15]; F.g_final = args.in[16];
    for (int u = F.tid; u < 256; u += NWAVES * 64) F.MISC[u] = 0u;
    __syncthreads();
#if !MK_PER_PHASE
    XcdBarrier bar = xcd_barrier_post((unsigned*)(F.ctl + CW_BAR), F.MISC + 200);
#define GRID_BAR() xcd_barrier(bar)
#else
#define GRID_BAR() do {} while (0)
#endif
    const int lo = args.ph_lo, hi = args.ph_hi;
#define IN(k) (lo <= (k) && (k) < hi)
#define BOTH(k) (IN(k) && IN((k) + 1))
    unsigned char* ws = args.ws;

#ifndef SKIP_P0
    if (IN(0)) { p0_prologue(F); if (BOTH(0)) GRID_BAR(); }
#endif

#ifndef SKIP_P1
    if (IN(1)) {
        { pg8::StaticOrder S; S.init(ws + WS_XB, ws + WS_WIN, NTOK, 2560, D, F.G, F.bx);
          EpiInProj E{(const float*)(ws + WS_RSTD1), (const float*)(ws + WS_META + META_LB), (bf16*)(ws + WS_SQ), (bf16*)(ws + WS_SK), (bf16*)(ws + WS_QT), (bf16*)(ws + WS_KT), (bf16*)(ws + WS_KH), (float*)(ws + WS_EGL), (bf16*)(ws + WS_HGS)};
          pg8::gemm_phase<EpiInProj, pg8::StaticOrder>(F.lds + RING_OFF, D, S, E); }
        { pg8::StaticOrder S; S.init(ws + WS_WIN + (size_t)2560 * D * 2, ws + WS_XB, 1024, NTOK, D, F.G, F.bx);
          EpiVT E{(const float*)(ws + WS_RSTD1), (bf16*)(ws + WS_VT)};
          pg8::gemm_phase<EpiVT, pg8::StaticOrder>(F.lds + RING_OFF, D, S, E); }
        if (BOTH(1)) GRID_BAR();
    }
#endif
#ifndef SKIP_P2
    if (IN(2)) { p2_hgrn<false>(F); if (PROBE_DUP == 2) p2_hgrn<false>(F); p2_attention(F); if (PROBE_DUP == 1) p2_attention(F); if (BOTH(2)) GRID_BAR(); }
    if (IN(3)) { p2_hgrn_scan(F); if (BOTH(3)) GRID_BAR(); }
    if (IN(4)) { p2_hgrn<true>(F); if (PROBE_DUP == 3) p2_hgrn<true>(F); if (BOTH(4)) GRID_BAR(); }
#endif
#ifndef SKIP_P3
    if (IN(5)) {
        pg8::StaticOrder S; S.init(ws + WS_MIXED, ws + WS_WOUT, NTOK, D, D, F.G, F.bx);
        EpiOutProj E{F.x, (float*)(ws + WS_H), (bf16*)(ws + WS_HB16)};
        pg8::gemm_phase<EpiOutProj, pg8::StaticOrder>(F.lds + RING_OFF, D, S, E);
        if (BOTH(5)) GRID_BAR();
    }
#endif
#ifndef SKIP_P4
    if (IN(6)) { p4_router(F); if (BOTH(6)) GRID_BAR(); }
#endif

#ifndef SKIP_P5
    if (IN(7)) {
        const int nunits = moe_setup(F, 0);
        MoeOrder<true> S{(const LAS int*)F.MISC, (const LAS int*)F.MISC + 40, (const LAS unsigned*)(F.lds + LIST_OFF), (const char*)(ws + WS_HB16), (const char*)(ws + WS_WGU), D, F.G, F.bx, nunits};
        EpiGateUp E{(const LAS float*)(F.lds + LIST_OFF + 8192), (bf16*)(ws + WS_HBUF)};
        pg8::gemm_phase<EpiGateUp, MoeOrder<true>>(F.lds + RING_OFF, D, S, E);
        if (BOTH(7)) GRID_BAR();
    }
#endif
#ifndef SKIP_P6
    if (IN(8)) {
        const int nunits = moe_setup(F, 1);
        MoeOrder<false> S{(const LAS int*)F.MISC, (const LAS int*)F.MISC + 40, (const LAS unsigned*)(F.lds + LIST_OFF), (const char*)(ws + WS_HBUF), (const char*)(ws + WS_WDN), FF, F.G, F.bx, nunits};
        EpiDown E{(const LAS unsigned*)(F.lds + LIST_OFF), (const LAS float*)(F.lds + LIST_OFF + 8192), (bf16*)(ws + WS_Y0), (bf16*)(ws + WS_Y1)};
        pg8::gemm_phase<EpiDown, MoeOrder<false>>(F.lds + RING_OFF, FF, S, E);
        if (BOTH(8)) GRID_BAR();
    }
#endif
#ifndef SKIP_P7
    if (IN(9)) p7_final(F);
#endif
#undef IN
#undef BOTH
}

extern "C" void kernel_launch(void* const* d_in, const int* in_sizes, int n_in, void* d_out, int out_size, void* d_ws, size_t ws_size, hipStream_t stream) {
    static int grid = 0;
    if (grid == 0) {
        if (n_in != 17 || in_sizes[0] != NTOK * D || out_size != NTOK * D || ws_size < WS_END) { fprintf(stderr, "kernel_launch: unexpected shapes (n_in %d, in0 %d, out %d, ws %zu)\n", n_in, n_in > 0 ? in_sizes[0] : -1, out_size, ws_size); grid = -1; return; }
        int dev = 0, cus = 0, per_cu = 0;
        if (hipGetDevice(&dev) != hipSuccess || hipDeviceGetAttribute(&cus, hipDeviceAttributeMultiprocessorCount, dev) != hipSuccess) { grid = -1; return; }
        if (hipFuncSetAttribute((const void*)hymba_fwd, hipFuncAttributeMaxDynamicSharedMemorySize, LDS_BYTES) != hipSuccess) { fprintf(stderr, "kernel_launch: hipFuncSetAttribute failed\n"); grid = -1; return; }
        if (hipOccupancyMaxActiveBlocksPerMultiprocessor(&per_cu, (const void*)hymba_fwd, NWAVES * 64, LDS_BYTES) != hipSuccess || per_cu < 1) { fprintf(stderr, "kernel_launch: occupancy query says %d\n", per_cu); }
        (void)hipGetLastError();
        grid = cus;
    }
    if (grid < 0) return;
    hipMemsetAsync((char*)d_ws + WS_CTL, 0, CTL_ZERO_BYTES, stream);
    Args a{};
    for (int i = 0; i < 17; ++i) a.in[i] = (const float*)d_in[i];
    a.out = (float*)d_out; a.ws = (unsigned char*)d_ws;
#if MK_PER_PHASE
    for (int p = 0; p < NPHASES; ++p) { a.ph_lo = p; a.ph_hi = p + 1; hipLaunchKernelGGL(hymba_fwd, dim3(grid), dim3(NWAVES * 64), LDS_BYTES, stream, a); }
#else
    a.ph_lo = 0; a.ph_hi = NPHASES; hipLaunchKernelGGL(hymba_fwd, dim3(grid), dim3(NWAVES * 64), LDS_BYTES, stream, a);
    if (PROBE_RELAUNCH >= 0) { a.ph_lo = PROBE_RELAUNCH; a.ph_hi = PROBE_RELAUNCH + 1; hipLaunchKernelGGL(hymba_fwd, dim3(grid), dim3(NWAVES * 64), LDS_BYTES, stream, a); }
#endif
}
```

```cpp
#include <hip/hip_runtime.h>
#include <cstdio>
#include <cstdint>

#define PROBE_RELAUNCH (-1)
#define PROBE_DUP 0
#define MK_PER_PHASE 0

namespace pg8 {
#define PG8_LAS __attribute__((address_space(3)))
typedef unsigned short bf16_t;
typedef short bf16x8 __attribute__((ext_vector_type(8)));
typedef float f32x4 __attribute__((ext_vector_type(4)));
typedef unsigned u32x4 __attribute__((ext_vector_type(4)));
constexpr int BM = 256, BK = 64, HALF = 128, HTB = HALF * BK * 2  , STAGE_BYTES = 8 * HTB, NXCD = 8, WGM = 8;

__host__ __device__ __forceinline__ int lds_byte(int r, int c) { const int st = (r >> 4) * 2 + (c >> 5), rr = r & 15, cc = c & 31, ob = rr * 64 + cc * 2; return st * 1024 + (ob ^ (((ob >> 9) & 1) << 5)); }
__host__ __device__ __forceinline__ void stage_rc(int b, int& R, int& C) { const int st = b / 1024, sb = b % 1024, swz = sb ^ (((sb >> 9) & 1) << 5); R = (st >> 1) * 16 + swz / 64; C = (st & 1) * 32 + (swz % 64) / 2; }
__host__ __device__ __forceinline__ int perm32(int rho) { const int n = rho >> 4, i = rho & 15; return 8 * (i >> 2) + 4 * n + (i & 3); }

struct Unit { int pm, pn, e, rows; };

struct StaticOrder {
    const char* A; const char* Bt; int K, nM, nN, nwg, G, c;
    __device__ void init(const void* A_, const void* Bt_, int M, int N, int K_, int G_, int c_) { A = (const char*)A_; Bt = (const char*)Bt_; K = K_; nM = M / BM; nN = N / BM; nwg = nM * nN; G = G_; c = c_; }
    __device__ bool next(int i, Unit& u) const {
        const long L = (long)i * G + c; if (L >= nwg) return false;
        int wgid = (int)L; { const int q = nwg / NXCD, r = nwg % NXCD, xcd = wgid % NXCD, off = wgid / NXCD; wgid = (xcd < r ? xcd * (q + 1) : r * (q + 1) + (xcd - r) * q) + off; }
        const int nig = WGM * nN, gid = wgid / nig, fm = gid * WGM, gsz = (nM - fm) < WGM ? (nM - fm) : WGM;
        u.pm = fm + ((wgid % nig) % gsz); u.pn = (wgid % nig) / gsz; u.e = 0; u.rows = BM; return true;
    }
    __device__ __forceinline__ const char* a_base(const Unit& u) const { return A + (size_t)u.pm * BM * K * 2; }
    __device__ __forceinline__ const char* b_base(const Unit& u) const { return Bt + (size_t)u.pn * BM * K * 2; }
    __device__ __forceinline__ void a_off(const Unit&, int, const int (&sR)[2], const int (&sC)[2], unsigned (&g)[2][2]) const {
#pragma unroll
        for (int h = 0; h < 2; ++h)
#pragma unroll
            for (int i = 0; i < 2; ++i) g[h][i] = (unsigned)((h * HALF + sR[i]) * K + sC[i]) * 2u;
    }
};

__device__ __forceinline__ unsigned cvt_pk_bf16(float lo, float hi) { unsigned r; asm volatile("v_cvt_pk_bf16_f32 %0, %1, %2" : "=v"(r) : "v"(lo), "v"(hi)); return r; }

template <class Epi, class Sched, bool ALIGN_EPI = true, bool SP2 = true>
__device__ __forceinline__ void gemm_phase(PG8_LAS unsigned char* lds, const int K, const Sched& S, const Epi& E) {
    const int tid = threadIdx.x, wid = __builtin_amdgcn_readfirstlane(tid >> 6), lane = tid & 63, wr = wid >> 2, wc = wid & 3, fr = lane & 15, fq = lane >> 4;
    const int nt = K / BK;
    unsigned voffB[2]; int sR[2], sC[2];
#pragma unroll
    for (int i = 0; i < 2; ++i) { int R, C; stage_rc(tid * 16 + i * 8192, R, C); sR[i] = R; sC[i] = C; const int Rb = Epi::PERM ? ((R & ~31) + perm32(R & 31)) : R; voffB[i] = (unsigned)(Rb * K + C) * 2u; }
    const size_t kstep = (size_t)(BK * 2);
    const size_t hstep = (size_t)HALF * K * 2;
    const unsigned ldsw = (unsigned)wid * 1024u;
    const int aoff = lds_byte(wr * 64 + fr, fq * 8), boff = lds_byte(wc * 32 + fr, fq * 8);
#define PG8_SA(b, h) (((b) * 2 + (h)) * HTB)
#define PG8_SB(b, h) ((4 + (b) * 2 + (h)) * HTB)
#define PG8_STAGE(bufoff, gbase, voff) do { _Pragma("unroll") for (int _i = 0; _i < 2; ++_i) \
        __builtin_amdgcn_global_load_lds((const unsigned*)((const char*)(gbase) + (voff)[_i]), (PG8_LAS unsigned*)(lds + (bufoff) + ldsw + _i * 8192), 16, 0, 0); } while (0)
#define PG8_LDA(dst, b, h) do { _Pragma("unroll") for (int m = 0; m < 4; ++m) _Pragma("unroll") for (int k = 0; k < 2; ++k) dst[m][k] = *(const PG8_LAS bf16x8*)(lds + PG8_SA(b, h) + aoff + m * 2048 + k * 1024); } while (0)
#define PG8_LDB(dst, b, h) do { _Pragma("unroll") for (int n = 0; n < 2; ++n) _Pragma("unroll") for (int k = 0; k < 2; ++k) dst[n][k] = *(const PG8_LAS bf16x8*)(lds + PG8_SB(b, h) + boff + n * 2048 + k * 1024); } while (0)
#define PG8_MMA(ai, bj, At, Bt) do { __builtin_amdgcn_s_setprio(1); _Pragma("unroll") for (int m = 0; m < 4; ++m) _Pragma("unroll") for (int n = 0; n < 2; ++n) _Pragma("unroll") for (int k = 0; k < 2; ++k) \
        acc[ai][bj][m][n] = __builtin_amdgcn_mfma_f32_16x16x32_bf16(Bt[n][k], At[m][k], acc[ai][bj][m][n], 0, 0, 0); __builtin_amdgcn_s_setprio(0); } while (0)
#define PG8_WAIT_V(n) asm volatile("s_waitcnt vmcnt(" #n ")" ::: "memory")
#define PG8_WAIT_L(n) asm volatile("s_waitcnt lgkmcnt(" #n ")" ::: "memory")
#define PG8_BAR __builtin_amdgcn_s_barrier()
#define PG8_SCHED __builtin_amdgcn_sched_barrier(0)
    Unit cur, nxt; int ui = 0;
    if (!S.next(0, cur)) return;
    f32x4 acc[2][2][4][2];
#pragma unroll
    for (int a = 0; a < 2; ++a)
#pragma unroll
        for (int b = 0; b < 2; ++b)
#pragma unroll
            for (int m = 0; m < 4; ++m)
#pragma unroll
                for (int n = 0; n < 2; ++n) acc[a][b][m][n] = (f32x4){0.f, 0.f, 0.f, 0.f};
    bf16x8 At[4][2], B0[2][2], B1[2][2];
    unsigned gc[2][2], gn[2][2];
    S.a_off(cur, 0, sR, sC, gc);
#pragma unroll
    for (int h = 0; h < 2; ++h)
#pragma unroll
        for (int i = 0; i < 2; ++i) gn[h][i] = gc[h][i];
    const char* cA = S.a_base(cur); const char* cB = S.b_base(cur);
    if constexpr (SP2) {
        PG8_STAGE(PG8_SB(0, 0), cB, voffB); PG8_STAGE(PG8_SB(0, 1), cB + hstep, voffB); PG8_STAGE(PG8_SA(0, 0), cA, gc[0]); PG8_STAGE(PG8_SA(0, 1), cA, gc[1]);
        if (wr == 1) PG8_BAR;
        PG8_WAIT_V(2); PG8_BAR;
        PG8_STAGE(PG8_SB(1, 0), cB + kstep, voffB); PG8_STAGE(PG8_SA(1, 0), cA + kstep, gc[0]); PG8_STAGE(PG8_SB(1, 1), cB + hstep + kstep, voffB);
        PG8_WAIT_V(6); PG8_BAR;
    } else {
        PG8_STAGE(PG8_SB(0, 0), cB, voffB); PG8_STAGE(PG8_SA(0, 0), cA, gc[0]); PG8_STAGE(PG8_SB(0, 1), cB + hstep, voffB); PG8_STAGE(PG8_SA(0, 1), cA, gc[1]);
        if (wr == 1) PG8_BAR;
        PG8_WAIT_V(4); PG8_BAR;
        PG8_STAGE(PG8_SB(1, 0), cB + kstep, voffB); PG8_STAGE(PG8_SA(1, 0), cA + kstep, gc[0]); PG8_STAGE(PG8_SB(1, 1), cB + hstep + kstep, voffB);
        PG8_WAIT_V(6); PG8_BAR;
    }
    for (;;) {
        const bool has_next = S.next(ui + 1, nxt);
        const char* nA = has_next ? S.a_base(nxt) : cA; const char* nB = has_next ? S.b_base(nxt) : cB;
        for (int t = 0; t < nt; t += 2) {
            const bool last = (t == nt - 2);
            const char* a1 = cA + (size_t)(t + 1) * kstep;
            const char* a2 = last ? nA : cA + (size_t)(t + 2) * kstep; const char* b2 = last ? nB : cB + (size_t)(t + 2) * kstep;
            const char* a3 = a2 + kstep; const char* b3 = b2 + kstep;
            if (last && has_next) S.a_off(nxt, ui + 1, sR, sC, gn);
            unsigned g2[2][2];
#pragma unroll
            for (int h = 0; h < 2; ++h)
#pragma unroll
                for (int i = 0; i < 2; ++i) g2[h][i] = last ? gn[h][i] : gc[h][i];
            if constexpr (SP2) {
            PG8_LDB(B0, 0, 0); PG8_LDB(B1, 0, 1); PG8_SCHED; PG8_LDA(At, 0, 0); PG8_STAGE(PG8_SA(1, 1), a1, gc[1]);
            PG8_WAIT_V(8); PG8_WAIT_L(0); PG8_BAR; PG8_MMA(0, 0, At, B0); PG8_MMA(0, 1, At, B1); PG8_BAR; PG8_SCHED;
            PG8_LDA(At, 0, 1); PG8_STAGE(PG8_SB(0, 0), b2, voffB); PG8_STAGE(PG8_SB(0, 1), b2 + hstep, voffB); PG8_STAGE(PG8_SA(0, 0), a2, g2[0]);
            PG8_WAIT_V(8); PG8_WAIT_L(0); PG8_BAR; PG8_MMA(1, 0, At, B0); PG8_MMA(1, 1, At, B1); PG8_BAR; PG8_SCHED;
            PG8_LDB(B0, 1, 0); PG8_LDB(B1, 1, 1); PG8_SCHED; PG8_LDA(At, 1, 0); PG8_STAGE(PG8_SA(0, 1), a2, g2[1]);
            PG8_WAIT_V(8); PG8_WAIT_L(0); PG8_BAR; PG8_MMA(0, 0, At, B0); PG8_MMA(0, 1, At, B1); PG8_BAR; PG8_SCHED;
            PG8_LDA(At, 1, 1); PG8_STAGE(PG8_SB(1, 0), b3, voffB); PG8_STAGE(PG8_SB(1, 1), b3 + hstep, voffB); PG8_STAGE(PG8_SA(1, 0), a3, g2[0]);
            PG8_WAIT_V(8); PG8_WAIT_L(0); PG8_BAR; PG8_MMA(1, 0, At, B0); PG8_MMA(1, 1, At, B1); PG8_BAR; PG8_SCHED;
            } else {
            PG8_LDB(B0, 0, 0); PG8_SCHED; PG8_LDA(At, 0, 0); PG8_STAGE(PG8_SA(1, 1), a1, gc[1]);
            PG8_WAIT_L(8); PG8_BAR; PG8_WAIT_L(0); PG8_MMA(0, 0, At, B0); PG8_BAR; PG8_SCHED;
            PG8_LDB(B1, 0, 1); PG8_STAGE(PG8_SB(0, 0), b2, voffB);
            PG8_BAR; PG8_WAIT_L(0); PG8_MMA(0, 1, At, B1); PG8_BAR;
            PG8_LDA(At, 0, 1); PG8_STAGE(PG8_SA(0, 0), a2, g2[0]);
            PG8_BAR; PG8_WAIT_L(0); PG8_MMA(1, 0, At, B0); PG8_BAR; PG8_SCHED;
            PG8_STAGE(PG8_SB(0, 1), b2 + hstep, voffB);
            PG8_WAIT_V(6); PG8_BAR; PG8_MMA(1, 1, At, B1); PG8_BAR;
            PG8_LDB(B0, 1, 0); PG8_SCHED; PG8_LDA(At, 1, 0); PG8_STAGE(PG8_SA(0, 1), a2, g2[1]);
            PG8_WAIT_L(8); PG8_BAR; PG8_WAIT_L(0); PG8_MMA(0, 0, At, B0); PG8_BAR; PG8_SCHED;
            PG8_LDB(B1, 1, 1); PG8_STAGE(PG8_SB(1, 0), b3, voffB);
            PG8_BAR; PG8_WAIT_L(0); PG8_MMA(0, 1, At, B1); PG8_BAR;
            PG8_LDA(At, 1, 1); PG8_STAGE(PG8_SA(1, 0), a3, g2[0]);
            PG8_BAR; PG8_WAIT_L(0); PG8_MMA(1, 0, At, B0); PG8_BAR; PG8_SCHED;
            PG8_STAGE(PG8_SB(1, 1), b3 + hstep, voffB);
            PG8_WAIT_V(6); PG8_BAR; PG8_MMA(1, 1, At, B1); PG8_BAR;
            }
        }
        if constexpr (ALIGN_EPI) { if (wr == 0) PG8_BAR; }
        E(acc, cur, ui, wr, wc, fr, fq);
        if (!has_next) break;
#pragma unroll
        for (int a = 0; a < 2; ++a)
#pragma unroll
            for (int b = 0; b < 2; ++b)
#pragma unroll
                for (int m = 0; m < 4; ++m)
#pragma unroll
                    for (int n = 0; n < 2; ++n) acc[a][b][m][n] = (f32x4){0.f, 0.f, 0.f, 0.f};
        cur = nxt; cA = nA; cB = nB; ++ui;
#pragma unroll
        for (int h = 0; h < 2; ++h)
#pragma unroll
            for (int i = 0; i < 2; ++i) gc[h][i] = gn[h][i];
        if constexpr (ALIGN_EPI) { if (wr == 1) PG8_BAR; }
    }
    PG8_WAIT_V(0);
    if constexpr (!ALIGN_EPI) { if (wr == 0) PG8_BAR; }
    PG8_BAR;
#undef PG8_SA
#undef PG8_SB
#undef PG8_STAGE
#undef PG8_LDA
#undef PG8_LDB
#undef PG8_MMA
#undef PG8_WAIT_V
#undef PG8_WAIT_L
#undef PG8_BAR
#undef PG8_SCHED
}
}

constexpr int NWAVES = 8;
constexpr int NB = 8, SEQ = 4096, D = 1024, NTOK = NB * SEQ, NPROJ = 3584, NMETA = 16;
constexpr int SBH = 8, SBD = 64, HGH = 4, HGD = 128;
constexpr int NE = 32, FF = 512, LCAP = NTOK;
constexpr float EPS = 1e-6f;
constexpr float QSCALE = 0.125f * 1.4426950408889634f;

constexpr size_t MiB = 1u << 20;
constexpr size_t WS_CTL = 0, CTL_ZERO_BYTES = 1 * MiB;
constexpr size_t WS_WIN = 1 * MiB, WS_WOUT = 8 * MiB, WS_WRT = 10 * MiB, WS_WGU = 11 * MiB, WS_WDN = 75 * MiB;
constexpr size_t WS_META = 107 * MiB;
constexpr size_t WS_RSTD1 = 108 * MiB;
constexpr size_t WS_LTOK = 109 * MiB, WS_LGATE = 113 * MiB, WS_LRSTD = 117 * MiB;
constexpr size_t WS_XB = 121 * MiB;
constexpr size_t WS_MIXED = WS_XB, WS_HBUF = WS_XB;
constexpr size_t WS_SQ = 193 * MiB, WS_SK = 225 * MiB, WS_VT = 257 * MiB, WS_QT = 321 * MiB, WS_KT = 353 * MiB, WS_KH = 385 * MiB, WS_HGS = 417 * MiB, WS_SST = 449 * MiB;
constexpr size_t WS_EGL = 109 * MiB;
constexpr size_t META_LB = 256 * 1024, META_KM = 320 * 1024, META_VTM = 352 * 1024, META_MKH = 384 * 1024;
constexpr size_t META_DUMMY0 = 0;
constexpr size_t WS_HB16 = 193 * MiB;
constexpr size_t WS_Y0 = 257 * MiB, WS_Y1 = 321 * MiB;
constexpr size_t WS_END = 481 * MiB;
constexpr int CW_TMO = 0, CW_CODE = 1, CW_BAR = 4096, CW_CNT = 8192;

constexpr int RING_OFF = 0, RING_BYTES = 131072;
constexpr int LIST_OFF = RING_BYTES, LIST_BYTES = 16384;
constexpr int MISC_OFF = LIST_OFF + LIST_BYTES;
constexpr int LDS_BYTES = MISC_OFF + 1024;
static_assert(LDS_BYTES <= 160 * 1024, "LDS");

#define GAS __attribute__((address_space(1)))
#define LAS __attribute__((address_space(3)))
typedef unsigned short bf16;
typedef unsigned v4u __attribute__((ext_vector_type(4)));
typedef unsigned v2u __attribute__((ext_vector_type(2)));
typedef float f32x4 __attribute__((ext_vector_type(4)));
typedef short bf16x8 __attribute__((ext_vector_type(8)));
typedef GAS unsigned gu32;
#define RLX_AGENT __ATOMIC_RELAXED, __HIP_MEMORY_SCOPE_AGENT
#define LDS_WAIT() asm volatile("s_waitcnt lgkmcnt(0)" ::: "memory")
__device__ __forceinline__ unsigned f2bf(float f) { unsigned u = __builtin_bit_cast(unsigned, f); return (u + 0x7fffu + ((u >> 16) & 1u)) >> 16; }
__device__ __forceinline__ unsigned pk2(float lo, float hi) { return f2bf(lo) | (f2bf(hi) << 16); }
__device__ __forceinline__ float bflo(unsigned u) { return __builtin_bit_cast(float, u << 16); }
__device__ __forceinline__ float bfhi(unsigned u) { return __builtin_bit_cast(float, u & 0xffff0000u); }
__device__ __forceinline__ float silu_f(float x) { return x * __builtin_amdgcn_rcpf(1.0f + __expf(-x)); }
__device__ __forceinline__ size_t frag_off(int chunk, int kg, int hh, int r) { return ((((size_t)chunk * 32 + kg) * 2 + hh) * 32 + r) * 8; }
__device__ __forceinline__ size_t vtf_off(int rb, int nch, int chunk, int sx, int hh, int c) { return (((((size_t)rb * nch + chunk) * 2 + sx) * 2 + hh) * 32 + c) * 8; }
__device__ __forceinline__ float wave_sum(float v) {
#pragma unroll
    for (int o = 1; o < 64; o <<= 1) v += __shfl_xor(v, o);
    return v;
}

#define XB_TMO      128
#define XB_XCNT(j)  (256  + 64 * (j))
#define XB_XSUB(j)  (1280 + 64 * (j))
#define XB_XGEN(j)  (2304 + 64 * (j))
#define XB_TOP      3328
#define XB_TOPGEN   3392
#define XCD_BAR_WORDS 3456
#define XB_SPIN_CAP (1u << 18)
__device__ __forceinline__ unsigned xb_ld(unsigned* p)              { return __hip_atomic_load(p, __ATOMIC_RELAXED, __HIP_MEMORY_SCOPE_AGENT); }
__device__ __forceinline__ unsigned xb_add(unsigned* p, unsigned v) { return __hip_atomic_fetch_add(p, v, __ATOMIC_RELAXED, __HIP_MEMORY_SCOPE_AGENT); }
__device__ __forceinline__ unsigned xb_xcc_id() { return (unsigned)__builtin_amdgcn_s_getreg((3 << 11) | 20) & 0xFu; }
#define XB_SPIN(cond, bar) do { unsigned _sp = 0; while (cond) { __builtin_amdgcn_s_sleep(1); \
    if ((++_sp & 255u) == 0u) { if (xb_ld(&(bar)[XB_TMO])) break; if (_sp > XB_SPIN_CAP) { atomicAdd(&(bar)[XB_TMO], 1u); break; } } } } while (0)
struct XcdBarrier { unsigned* bar; unsigned x; volatile LAS unsigned* st; };
__device__ __forceinline__ XcdBarrier xcd_barrier_post(unsigned* bar, volatile LAS unsigned* st) {
    XcdBarrier b; b.bar = bar; b.x = xb_xcc_id(); b.st = st;
    if (threadIdx.x == 0) (void)xb_add(&bar[XB_XCNT(b.x)], 1u);
    return b;
}
__device__ __forceinline__ void xcd_barrier_complete(unsigned* bar, unsigned x, unsigned& nloc, unsigned& nx) {
    const unsigned G = gridDim.x * gridDim.y * gridDim.z;
    unsigned sum, cnt, mine, sp = 0u;
    for (;;) {
        sum = 0u; cnt = 0u; mine = 0u;
#pragma unroll
        for (unsigned j = 0; j < 16; ++j) { const unsigned c = xb_ld(&bar[XB_XCNT(j)]); sum += c; cnt += (c > 0u) ? 1u : 0u; mine = (j == x) ? c : mine; }
        if (sum == G) break;
        __builtin_amdgcn_s_sleep(1);
        if ((++sp & 255u) == 0u) { if (xb_ld(&bar[XB_TMO])) break; if (sp > XB_SPIN_CAP) { atomicAdd(&bar[XB_TMO], 1u); break; } }
    }
    nloc = mine > 0u ? mine : 1u; nx = cnt > 0u ? cnt : 1u;
}
__device__ __forceinline__ void xcd_barrier(const XcdBarrier& b) {
    asm volatile("s_waitcnt vmcnt(0)" ::: "memory");
    __syncthreads();
    if (threadIdx.x == 0) {
        unsigned* bar = b.bar;
        __builtin_amdgcn_s_waitcnt(0);
        unsigned nloc = b.st[0], nx = b.st[1];
        if (nloc == 0u) { xcd_barrier_complete(bar, b.x, nloc, nx); b.st[0] = nloc; b.st[1] = nx; }
        const unsigned old = xb_add(&bar[XB_XSUB(b.x)], 1u);
        const unsigned gen = old / nloc;
        if (old + 1u == (gen + 1u) * nloc) {
            __builtin_amdgcn_fence(__ATOMIC_RELEASE, "agent");
            asm volatile("s_waitcnt vmcnt(0)" ::: "memory");
            const unsigned og = xb_add(&bar[XB_TOP], 1u);
            const unsigned tg = og / nx;
            if (og + 1u == (tg + 1u) * nx) xb_add(&bar[XB_TOPGEN], 1u);
            else XB_SPIN(xb_ld(&bar[XB_TOPGEN]) == tg, bar);
            __builtin_amdgcn_fence(__ATOMIC_ACQUIRE, "agent");
            xb_add(&bar[XB_XGEN(b.x)], 1u);
            asm volatile("s_waitcnt vmcnt(0)" ::: "memory");
        } else {
            XB_SPIN(xb_ld(&bar[XB_XGEN(b.x)]) == gen, bar);
            __builtin_amdgcn_fence(__ATOMIC_ACQUIRE, "agent");
            asm volatile("s_waitcnt vmcnt(0)" ::: "memory");
        }
    }
    __syncthreads();
}

struct Args { const float* in[17]; float* out; unsigned char* ws; int ph_lo, ph_hi; };
struct Frame {
    LAS unsigned char* lds; volatile LAS unsigned* MISC; gu32* ctl; unsigned char* ws;
    int tid, lane, wave, G, bx;
    const float *x, *meta, *lb_logits, *g_mix, *w_in, *sb_gain, *hg_gain, *w_out, *g_ffn, *w_rg, *b_rg, *w_re, *b_re, *w_gate, *w_up, *w_down, *g_final;
    float* out;
};

__device__ __forceinline__ void p0_transpose_item(const float* W, int ldw, int srcc0, int k0, bf16* WT, int Kd, int dstr0, const float* gain, LAS float* scr, int lane) {
    float v[32]; const float* wp = W + (size_t)(k0 + (lane >> 5)) * ldw + srcc0 + (lane & 31);
#pragma unroll
    for (int i = 0; i < 32; ++i) v[i] = wp[(size_t)(2 * i) * ldw];
    if (gain) {
#pragma unroll
        for (int i = 0; i < 32; ++i) v[i] *= gain[k0 + 2 * i + (lane >> 5)]; }
#pragma unroll
    for (int i = 0; i < 32; ++i) scr[(2 * i + (lane >> 5)) * 33 + (lane & 31)] = v[i];
    LDS_WAIT(); asm volatile("" ::: "memory");
    const int c = lane & 7;
#pragma unroll
    for (int j = 0; j < 4; ++j) { const int n = (lane >> 3) + 8 * j; const LAS float* s = scr + (8 * c) * 33 + n;
        v4u o; o.x = pk2(s[0 * 33], s[1 * 33]); o.y = pk2(s[2 * 33], s[3 * 33]); o.z = pk2(s[4 * 33], s[5 * 33]); o.w = pk2(s[6 * 33], s[7 * 33]);
        *(GAS v4u*)(WT + (size_t)(dstr0 + n) * Kd + k0 + 8 * c) = o; }
    LDS_WAIT(); asm volatile("" ::: "memory");
}
__device__ __forceinline__ void p0_prologue(Frame& F) {
    unsigned char* ws = F.ws;
    const int gw = F.bx * NWAVES + F.wave, NGW = F.G * NWAVES;
    {
        LAS float* am = (LAS float*)(F.lds);
        LAS float* red = (LAS float*)(F.lds + 65536);
        for (int r = F.wave * 2; r < F.wave * 2 + 2; ++r) {
            const GAS f32x4* xr = (const GAS f32x4*)(F.meta + (size_t)r * D) + F.lane; f32x4 v[4]; float s = 0.f;
#pragma unroll
            for (int j = 0; j < 4; ++j) { v[j] = xr[64 * j]; s += (v[j].x * v[j].x + v[j].y * v[j].y) + (v[j].z * v[j].z + v[j].w * v[j].w); }
            const float rstd = 1.0f / sqrtf(wave_sum(s) * (1.f / D) + EPS);
#pragma unroll
            for (int j = 0; j < 4; ++j) { const int k = 4 * F.lane + 256 * j; const f32x4 g = *(const GAS f32x4*)(F.g_mix + k);
                am[r * D + k + 0] = v[j].x * rstd * g.x; am[r * D + k + 1] = v[j].y * rstd * g.y; am[r * D + k + 2] = v[j].z * rstd * g.z; am[r * D + k + 3] = v[j].w * rstd * g.w; }
        }
        __syncthreads();
        for (int cb = F.bx; cb < NPROJ / 14; cb += F.G) {
            if (F.tid < 448) { const int c = F.tid % 14, ks = F.tid / 14, col = cb * 14 + c; float a[16];
#pragma unroll
                for (int r = 0; r < 16; ++r) a[r] = 0.f;
                for (int k = ks * 32; k < ks * 32 + 32; ++k) { const float w = F.w_in[(size_t)k * NPROJ + col];
#pragma unroll
                    for (int r = 0; r < 16; ++r) a[r] += am[r * D + k] * w; }
#pragma unroll
                for (int r = 0; r < 16; ++r) red[(ks * 14 + c) * 16 + r] = a[r]; }
            __syncthreads();
            if (F.tid < 224) { const int c = F.tid / 16, r = F.tid % 16; float s = 0.f;
                for (int ks = 0; ks < 32; ++ks) s += red[(ks * 14 + c) * 16 + r];
                red[c * 16 + r] = s;
                const int col = cb * 14 + c; ((float*)(ws + WS_META))[r * NPROJ + col] = s;
                if (col >= 512 && col < 1024) { bf16* KM = (bf16*)(ws + WS_META + META_KM); const int d = col - 512; KM[frag_off(0, d >> 4, (d >> 3) & 1, r) + (d & 7)] = (bf16)f2bf(s); KM[frag_off(0, d >> 4, (d >> 3) & 1, 16 + r) + (d & 7)] = 0; }
                if (col >= 1024 && col < 1536) { bf16* VTM = (bf16*)(ws + WS_META + META_VTM); const int d = col - 1024, jj = (r & 3) + 4 * (r >> 3), hq = (r >> 2) & 1; VTM[vtf_off(d >> 5, 1, 0, 0, hq, d & 31) + jj] = (bf16)f2bf(s); VTM[vtf_off(d >> 5, 1, 0, 1, hq, d & 31) + jj] = 0; } }
            __syncthreads();
            if (F.tid < 14) { const int col = cb * 14 + F.tid;
                if (col >= 2048 && col < 2560) { const int d = col - 2048; const float la = F.lb_logits[d], lb2 = F.lb_logits[512 + d], mx = fmaxf(la, lb2), ea = __expf(la - mx), eb = __expf(lb2 - mx), lb = ea / (ea + eb);
                    float Gs[16], ks[16], G = 0.f;
#pragma unroll
                    for (int r = 0; r < 16; ++r) { const float xx = red[F.tid * 16 + r], sg = 1.0f / (1.0f + __expf(-xx)), f = lb + (1.f - lb) * sg; G += __logf(f); Gs[r] = G; ks[r] = (1.f - lb) * (1.f - sg); }
#pragma unroll
                    for (int r = 0; r < 16; ++r) ((float*)(ws + WS_META + META_MKH))[r * 512 + d] = ks[r] * __expf(G - Gs[r]); } }
            __syncthreads();
        }
    }
    if (F.bx == (1 % F.G)) { float* LB = (float*)(ws + WS_META + META_LB); const float a = F.lb_logits[F.tid], b = F.lb_logits[512 + F.tid], m = fmaxf(a, b), ea = __expf(a - m), eb = __expf(b - m); LB[F.tid] = ea / (ea + eb); }
    for (int i = F.bx * 512 + F.tid; i < 48 * D; i += F.G * 512) { const int e = i / D, k = i % D; float v = 0.f; if (e < 4) v = F.w_rg[k * 4 + e]; else if (e < 36) v = F.w_re[k * 32 + (e - 4)]; ((bf16*)(ws + WS_WRT))[i] = (bf16)f2bf(v * F.g_ffn[k]); }
    {
        LAS float* scr = (LAS float*)(F.lds + RING_OFF + F.wave * 16384);
        constexpr int I_IN = (D / 64) * (NPROJ / 32), I_OUT = (D / 64) * (D / 32), I_GU = NE * (D / 64) * (1024 / 32), I_DN = NE * (FF / 64) * (D / 32);
        constexpr int NITEMS = I_IN + I_OUT + I_GU + I_DN;
        for (int it = gw; it < NITEMS; it += NGW) {
            int r = it;
            if (r < I_IN) { const int nb = r % (NPROJ / 32), kb = r / (NPROJ / 32), r0 = 32 * nb; int src;
                if (r0 < 1024) src = r0; else if (r0 < 2048) { const int q = r0 - 1024, blk = q / 256, wi = q % 256; src = (wi >= 128 ? 2048 : 1536) + 128 * blk + (wi % 128); }
                else if (r0 < 2560) src = 3072 + (r0 - 2048); else if (r0 < 3072) src = 1024 + (r0 - 2560); else src = 2560 + (r0 - 3072);
                p0_transpose_item(F.w_in, NPROJ, src, 64 * kb, (bf16*)(ws + WS_WIN), D, 32 * nb, F.g_mix, scr, F.lane); continue; } r -= I_IN;
            if (r < I_OUT) { const int nb = r % (D / 32), kb = r / (D / 32); p0_transpose_item(F.w_out, D, 32 * nb, 64 * kb, (bf16*)(ws + WS_WOUT), D, 32 * nb, nullptr, scr, F.lane); continue; } r -= I_OUT;
            if (r < I_GU) { const int e = r / (16 * 32), q = r % (16 * 32), nb = q % 32, kb = q / 32, pn = nb / 8, half = (nb % 8) / 4, i0 = (nb % 4) * 32;
                const float* src = (half ? F.w_up : F.w_gate) + (size_t)e * D * FF;
                p0_transpose_item(src, FF, 128 * pn + i0, 64 * kb, (bf16*)(ws + WS_WGU) + (size_t)e * 1024 * D, D, 32 * nb, F.g_ffn, scr, F.lane); continue; } r -= I_GU;
            { const int e = r / (8 * 32), q = r % (8 * 32), nb = q % 32, kb = q / 32;
                p0_transpose_item(F.w_down + (size_t)e * FF * D, D, 32 * nb, 64 * kb, (bf16*)(ws + WS_WDN) + (size_t)e * D * FF, FF, 32 * nb, nullptr, scr, F.lane); }
        }
    }
    for (int m0 = gw * 4; m0 < NTOK; m0 += NGW * 4) {
        f32x4 v[4][4];
#pragma unroll
        for (int r = 0; r < 4; ++r) { const GAS f32x4* xr = (const GAS f32x4*)(F.x + (size_t)(m0 + r) * D) + F.lane;
#pragma unroll
            for (int j = 0; j < 4; ++j) v[r][j] = __builtin_nontemporal_load(xr + 64 * j); }
#pragma unroll
        for (int r = 0; r < 4; ++r) { float s = 0.f;
#pragma unroll
            for (int j = 0; j < 4; ++j) s += (v[r][j].x * v[r][j].x + v[r][j].y * v[r][j].y) + (v[r][j].z * v[r][j].z + v[r][j].w * v[r][j].w);
            s = wave_sum(s);
            if (F.lane == 0) ((float*)(ws + WS_RSTD1))[m0 + r] = 1.0f / sqrtf(s * (1.f / D) + EPS);
            GAS v2u* o8 = (GAS v2u*)((bf16*)(ws + WS_XB) + (size_t)(m0 + r) * D) + F.lane;
#pragma unroll
            for (int j = 0; j < 4; ++j) { v2u w; w.x = pk2(v[r][j].x, v[r][j].y); w.y = pk2(v[r][j].z, v[r][j].w); o8[64 * j] = w; } }
    }
}

struct EpiInProj {
    static constexpr bool PERM = true;
    const float* rstd; const float* LB; bf16* SQ; bf16* SK; bf16* QT; bf16* KT; bf16* KH; float* EGL; bf16* HGS;
    __device__ __forceinline__ void operator()(const pg8::f32x4 (&acc)[2][2][4][2], const pg8::Unit& u, int, int wr, int wc, int fr, int fq) const {
        const int row0 = u.pm * 256 + wr * 64 + fr, cl = wc * 32 + 8 * fq;
        if (u.pn >= 4 && u.pn < 8) {
            const int c0 = (u.pn - 4) * 128 + cl;
            const f32x4 lb0 = *(const f32x4*)(LB + c0), lb1 = *(const f32x4*)(LB + c0 + 4);
#pragma unroll
            for (int ai = 0; ai < 2; ++ai)
#pragma unroll
                for (int mp = 0; mp < 2; ++mp) {
                    const int rA = row0 + ai * 128 + mp * 32, rB = rA + 16; const float rsA = rstd[rA], rsB = rstd[rB];
                    float qt[2][8], kt[2][8], kh[2][8], egl[8];
#pragma unroll
                    for (int cc = 0; cc < 8; ++cc) {
                        const float lb = cc < 4 ? lb0[cc & 3] : lb1[cc & 3];
                        const float xq0 = acc[ai][0][2 * mp][cc >> 2][cc & 3] * rsA, xq1 = acc[ai][0][2 * mp + 1][cc >> 2][cc & 3] * rsB;
                        const float xf0 = acc[ai][1][2 * mp][cc >> 2][cc & 3] * rsA, xf1 = acc[ai][1][2 * mp + 1][cc >> 2][cc & 3] * rsB;
                        const float sg0 = __builtin_amdgcn_rcpf(1.f + __expf(-xf0)), sg1 = __builtin_amdgcn_rcpf(1.f + __expf(-xf1));
                        const float k0 = (1.f - lb) * (1.f - sg0), k1 = (1.f - lb) * (1.f - sg1);
                        float s0 = __logf(lb + (1.f - lb) * sg0), s1 = __logf(lb + (1.f - lb) * sg1);
#pragma unroll
                        for (int dd = 1; dd < 16; dd <<= 1) { const float y0 = __shfl_up(s0, dd, 16), y1 = __shfl_up(s1, dd, 16); if (fr >= dd) { s0 += y0; s1 += y1; } }
                        s1 += __shfl(s0, 15, 16);
                        const float GL = __shfl(s1, 15, 16);
                        qt[0][cc] = silu_f(xq0) * __expf(s0); qt[1][cc] = silu_f(xq1) * __expf(s1);
                        kt[0][cc] = k0 * __expf(-s0); kt[1][cc] = k1 * __expf(-s1);
                        kh[0][cc] = k0 * __expf(GL - s0); kh[1][cc] = k1 * __expf(GL - s1);
                        egl[cc] = __expf(GL);
                    }
#pragma unroll
                    for (int par = 0; par < 2; ++par) { const int rr = par ? rB : rA; const size_t p0 = frag_off(rr >> 5, c0 >> 4, 0, rr & 31) + 4 * ((c0 >> 3) & 1), p1 = p0 + 32 * 8; v2u w;
                        w.x = pg8::cvt_pk_bf16(qt[par][0], qt[par][1]); w.y = pg8::cvt_pk_bf16(qt[par][2], qt[par][3]); *(v2u*)(QT + p0) = w; w.x = pg8::cvt_pk_bf16(qt[par][4], qt[par][5]); w.y = pg8::cvt_pk_bf16(qt[par][6], qt[par][7]); *(v2u*)(QT + p1) = w;
                        w.x = pg8::cvt_pk_bf16(kt[par][0], kt[par][1]); w.y = pg8::cvt_pk_bf16(kt[par][2], kt[par][3]); *(v2u*)(KT + p0) = w; w.x = pg8::cvt_pk_bf16(kt[par][4], kt[par][5]); w.y = pg8::cvt_pk_bf16(kt[par][6], kt[par][7]); *(v2u*)(KT + p1) = w;
                        pg8::u32x4 w4; w4.x = pg8::cvt_pk_bf16(kh[par][0], kh[par][1]); w4.y = pg8::cvt_pk_bf16(kh[par][2], kh[par][3]); w4.z = pg8::cvt_pk_bf16(kh[par][4], kh[par][5]); w4.w = pg8::cvt_pk_bf16(kh[par][6], kh[par][7]);
                        *(pg8::u32x4*)(KH + frag_off(rr >> 5, c0 >> 4, (c0 >> 3) & 1, rr & 31)) = w4; }
                    if (fr == 15) { float* ep = EGL + (size_t)(rA >> 5) * 512 + c0; *(f32x4*)ep = (f32x4){egl[0], egl[1], egl[2], egl[3]}; *(f32x4*)(ep + 4) = (f32x4){egl[4], egl[5], egl[6], egl[7]}; }
                }
            return;
        }
        const int kind = u.pn < 2 ? 0 : (u.pn < 4 ? 1 : 2);
#pragma unroll
        for (int ai = 0; ai < 2; ++ai)
#pragma unroll
            for (int m = 0; m < 4; ++m) {
                const int row = row0 + ai * 128 + m * 16; const float rs = rstd[row];
#pragma unroll
                for (int bj = 0; bj < 2; ++bj) {
                    f32x4 v0 = acc[ai][bj][m][0] * rs, v1 = acc[ai][bj][m][1] * rs;
                    if (kind == 0) { v0 = v0 * QSCALE; v1 = v1 * QSCALE; }
                    if (kind == 2) {
#pragma unroll
                        for (int j = 0; j < 4; ++j) { v0[j] = silu_f(v0[j]); v1[j] = silu_f(v1[j]); } }
                    pg8::u32x4 w; w.x = pg8::cvt_pk_bf16(v0[0], v0[1]); w.y = pg8::cvt_pk_bf16(v0[2], v0[3]); w.z = pg8::cvt_pk_bf16(v1[0], v1[1]); w.w = pg8::cvt_pk_bf16(v1[2], v1[3]);
                    if (u.pn < 4) { const int c8 = (u.pn & 1) * 256 + bj * 128 + cl; *(pg8::u32x4*)((u.pn < 2 ? SQ : SK) + frag_off(row >> 5, c8 >> 4, (c8 >> 3) & 1, row & 31)) = w; }
                    else *(pg8::u32x4*)(HGS + (size_t)row * 512 + (u.pn - 8) * 256 + bj * 128 + cl) = w;
                }
            }
    }
};
struct EpiVT {
    static constexpr bool PERM = true;
    const float* rstd; bf16* VT;
    __device__ __forceinline__ void operator()(const pg8::f32x4 (&acc)[2][2][4][2], const pg8::Unit& u, int, int wr, int wc, int fr, int fq) const {
        const int row0 = u.pm * 256 + wr * 64 + fr, col0 = u.pn * 256 + wc * 32 + 8 * fq;
        f32x4 rsv[2][2];
#pragma unroll
        for (int bj = 0; bj < 2; ++bj)
#pragma unroll
            for (int n = 0; n < 2; ++n) rsv[bj][n] = *(const f32x4*)(rstd + col0 + bj * 128 + 4 * n);
#pragma unroll
        for (int ai = 0; ai < 2; ++ai)
#pragma unroll
            for (int m = 0; m < 4; ++m) {
                const int wrow = row0 + ai * 128 + m * 16;
#pragma unroll
                for (int bj = 0; bj < 2; ++bj) { const f32x4 v0 = acc[ai][bj][m][0] * rsv[bj][0], v1 = acc[ai][bj][m][1] * rsv[bj][1];
                    const int t0 = col0 + bj * 128; const size_t p0 = vtf_off(wrow >> 5, NTOK / 32, t0 >> 5, (t0 >> 4) & 1, 0, wrow & 31) + 4 * ((t0 >> 3) & 1);
                    v2u w; w.x = pg8::cvt_pk_bf16(v0[0], v0[1]); w.y = pg8::cvt_pk_bf16(v0[2], v0[3]); *(v2u*)(VT + p0) = w;
                    w.x = pg8::cvt_pk_bf16(v1[0], v1[1]); w.y = pg8::cvt_pk_bf16(v1[2], v1[3]); *(v2u*)(VT + p0 + 32 * 8) = w; }
            }
    }
};
struct EpiOutProj {
    static constexpr bool PERM = true;
    const float* x; bf16* HB16;
    __device__ __forceinline__ void operator()(const pg8::f32x4 (&acc)[2][2][4][2], const pg8::Unit& u, int, int wr, int wc, int fr, int fq) const {
        const int row0 = u.pm * 256 + wr * 64 + fr, col0 = u.pn * 256 + wc * 32 + 8 * fq;
#pragma unroll
        for (int ai = 0; ai < 2; ++ai)
#pragma unroll
            for (int m = 0; m < 4; ++m) {
                const size_t ro = (size_t)(row0 + ai * 128 + m * 16) * D + col0;
                f32x4 xv[2][2];
#pragma unroll
                for (int bj = 0; bj < 2; ++bj) { xv[bj][0] = __builtin_nontemporal_load((const f32x4*)(x + ro + bj * 128)); xv[bj][1] = __builtin_nontemporal_load((const f32x4*)(x + ro + bj * 128 + 4)); }
#pragma unroll
                for (int bj = 0; bj < 2; ++bj) {
                    const f32x4 v0 = acc[ai][bj][m][0] + xv[bj][0], v1 = acc[ai][bj][m][1] + xv[bj][1];
                    pg8::u32x4 w; w.x = pg8::cvt_pk_bf16(v0[0], v0[1]); w.y = pg8::cvt_pk_bf16(v0[2], v0[3]); w.z = pg8::cvt_pk_bf16(v1[0], v1[1]); w.w = pg8::cvt_pk_bf16(v1[2], v1[3]);
                    *(pg8::u32x4*)(HB16 + ro + bj * 128) = w;
                }
            }
    }
};
struct EpiGateUp {
    static constexpr bool PERM = true;
    const LAS float* lrstd; bf16* HBUF;
    __device__ __forceinline__ void operator()(const pg8::f32x4 (&acc)[2][2][4][2], const pg8::Unit& u, int ord, int wr, int wc, int fr, int fq) const {
        const int rl0 = wr * 64 + fr, col0 = u.pn * 128 + wc * 32 + 8 * fq;
#pragma unroll
        for (int ai = 0; ai < 2; ++ai)
#pragma unroll
            for (int m = 0; m < 4; ++m) {
                const int rl = rl0 + ai * 128 + m * 16; const float rs = lrstd[ord * 256 + rl];
                const f32x4 g0 = acc[ai][0][m][0] * rs, g1 = acc[ai][0][m][1] * rs, u0 = acc[ai][1][m][0] * rs, u1 = acc[ai][1][m][1] * rs;
                float h[8];
#pragma unroll
                for (int j = 0; j < 4; ++j) { h[j] = silu_f(g0[j]) * u0[j]; h[4 + j] = silu_f(g1[j]) * u1[j]; }
                pg8::u32x4 w; w.x = pg8::cvt_pk_bf16(h[0], h[1]); w.y = pg8::cvt_pk_bf16(h[2], h[3]); w.z = pg8::cvt_pk_bf16(h[4], h[5]); w.w = pg8::cvt_pk_bf16(h[6], h[7]);
                *(pg8::u32x4*)(HBUF + (size_t)(u.pm * 256 + rl) * FF + col0) = w;
            }
    }
};
struct EpiDown {
    static constexpr bool PERM = true;
    const LAS unsigned* ltok; const LAS float* lgate; bf16* Y0; bf16* Y1;
    __device__ __forceinline__ void operator()(const pg8::f32x4 (&acc)[2][2][4][2], const pg8::Unit& u, int ord, int wr, int wc, int fr, int fq) const {
        const int rl0 = wr * 64 + fr, col0 = u.pn * 256 + wc * 32 + 8 * fq;
#pragma unroll
        for (int ai = 0; ai < 2; ++ai)
#pragma unroll
            for (int m = 0; m < 4; ++m) {
                const int rl = rl0 + ai * 128 + m * 16; const unsigned tp = ltok[ord * 256 + rl]; const float gt = lgate[ord * 256 + rl];
                if (!(tp & 0x80000000u)) {
                    bf16* yb = ((tp >> 30) & 1u) ? Y1 : Y0; const size_t ro = (size_t)(tp & 0xffffu) * D + col0;
#pragma unroll
                    for (int bj = 0; bj < 2; ++bj) { const f32x4 v0 = acc[ai][bj][m][0] * gt, v1 = acc[ai][bj][m][1] * gt;
                        pg8::u32x4 w; w.x = pg8::cvt_pk_bf16(v0[0], v0[1]); w.y = pg8::cvt_pk_bf16(v0[2], v0[3]); w.z = pg8::cvt_pk_bf16(v1[0], v1[1]); w.w = pg8::cvt_pk_bf16(v1[2], v1[3]);
                        *(pg8::u32x4*)(yb + ro + bj * 128) = w; }
                }
            }
    }
};
template <bool GATHER> struct MoeOrder {
    const LAS int* tstart; const LAS int* cntl; const LAS unsigned* ltok; const char* A; const char* Bt; int K, G, c, nunits;
    __device__ bool next(int i, pg8::Unit& u) const {
        const int L = i * G + c; if (L >= nunits) return false;
        const int rt = L >> 2; int e = 0;
        while (e < NE - 1 && tstart[e + 1] <= rt) ++e;
        e = __builtin_amdgcn_readfirstlane(e);
        u.pm = rt; u.pn = L & 3; u.e = e; const int left = cntl[e] - (rt - tstart[e]) * 256; u.rows = __builtin_amdgcn_readfirstlane(left < 256 ? left : 256); return true;
    }
    __device__ __forceinline__ const char* a_base(const pg8::Unit& u) const { return GATHER ? A : A + (size_t)u.pm * 256 * K * 2; }
    __device__ __forceinline__ const char* b_base(const pg8::Unit& u) const { return Bt + ((size_t)u.e * 1024 + (size_t)u.pn * 256) * K * 2; }
    __device__ __forceinline__ void a_off(const pg8::Unit&, int ord, const int (&sR)[2], const int (&sC)[2], unsigned (&g)[2][2]) const {
#pragma unroll
        for (int h = 0; h < 2; ++h)
#pragma unroll
            for (int i = 0; i < 2; ++i) {
                if (GATHER) g[h][i] = ((ltok[ord * 256 + h * 128 + sR[i]] & 0xffffu) * (unsigned)K + (unsigned)sC[i]) * 2u;
                else g[h][i] = (unsigned)((h * 128 + sR[i]) * K + sC[i]) * 2u;
            }
    }
};
__device__ __forceinline__ int moe_setup(Frame& F, int which  ) {
    volatile LAS int* M = (volatile LAS int*)F.MISC;
    if (F.tid < NE) M[40 + F.tid] = (int)__hip_atomic_load(F.ctl + CW_CNT + 64 * F.tid, RLX_AGENT);
    __syncthreads();
    if (F.tid == 0) { int s = 0; for (int e = 0; e < NE; ++e) { M[e] = s; s += (M[40 + e] + 255) >> 8; } M[NE] = s; }
    __syncthreads();
    const int nrt = M[NE], nunits = nrt * 4;
    LAS unsigned* ltok = (LAS unsigned*)(F.lds + LIST_OFF); LAS float* lval = (LAS float*)(F.lds + LIST_OFF + 8192);
    const unsigned* LT = (const unsigned*)(F.ws + WS_LTOK); const float* LV = (const float*)(F.ws + (which ? WS_LGATE : WS_LRSTD));
    for (int i = 0; i < 8; ++i) {
        const int L = i * F.G + F.bx; if (L >= nunits) break;
        const int rt = L >> 2; int e = 0; while (e < NE - 1 && M[e + 1] <= rt) ++e;
        if (F.tid < 256) { const int idx = (rt - M[e]) * 256 + F.tid; const bool ok = idx < M[40 + e];
            ltok[i * 256 + F.tid] = ok ? LT[(size_t)e * LCAP + idx] : 0x80000000u; lval[i * 256 + F.tid] = ok ? LV[(size_t)e * LCAP + idx] : 0.f; }
    }
    __syncthreads();
    return nunits;
}

typedef float f32x16 __attribute__((ext_vector_type(16)));
__device__ __forceinline__ void p2_attention(Frame& F) {
    const bf16* SQ = (const bf16*)(F.ws + WS_SQ); const bf16* SK = (const bf16*)(F.ws + WS_SK); const bf16* VT = (const bf16*)(F.ws + WS_VT);
    const bf16* KM = (const bf16*)(F.ws + WS_META + META_KM); const bf16* VTM = (const bf16*)(F.ws + WS_META + META_VTM); bf16* MIX = (bf16*)(F.ws + WS_MIXED);
    const int c = F.lane & 31, hh = F.lane >> 5;
    const int gw = F.bx * NWAVES + F.wave, NGW = F.G * NWAVES;
    for (int item = gw; item < NB * SBH * (SEQ / 32); item += NGW) {
        const int qb = item & 127, h = (item >> 7) & 7, b = item >> 10;
        const size_t tok0 = (size_t)b * SEQ;
        bf16x8 qf[4];
        const int ch0 = (int)(tok0 >> 5);
#pragma unroll
        for (int ks = 0; ks < 4; ++ks) qf[ks] = *(const bf16x8*)(SQ + frag_off(ch0 + qb, h * 4 + ks, hh, c));
        f32x16 o0, o1;
#pragma unroll
        for (int i = 0; i < 16; ++i) { o0[i] = 0.f; o1[i] = 0.f; }
        float R = 0.f;
        for (int kt = qb; kt >= -1; --kt) {
            const bf16* kp = kt >= 0 ? SK + frag_off(ch0 + kt, h * 4, hh, c) : KM + frag_off(0, h * 4, hh, c);
            const bf16* vp = kt >= 0 ? VT + vtf_off(2 * h, NTOK / 32, ch0 + kt, 0, hh, c) : VTM + vtf_off(2 * h, 1, 0, 0, hh, c);
            const size_t vblk = kt >= 0 ? (size_t)(NTOK / 32) * 1024 : (size_t)1024;
            bf16x8 kf[4];
#pragma unroll
            for (int ks = 0; ks < 4; ++ks) kf[ks] = *(const bf16x8*)(kp + ks * 512);
            bf16x8 vfr[2][2];
#pragma unroll
            for (int bl = 0; bl < 2; ++bl)
#pragma unroll
                for (int sx = 0; sx < 2; ++sx) vfr[bl][sx] = *(const bf16x8*)(vp + bl * vblk + sx * 512);
            f32x16 st;
#pragma unroll
            for (int i = 0; i < 16; ++i) st[i] = 0.f;
#pragma unroll
            for (int ks = 0; ks < 4; ++ks) st = __builtin_amdgcn_mfma_f32_32x32x16_bf16(kf[ks], qf[ks], st, 0, 0, 0);
            const bool diag = (kt == qb), meta = (kt < 0);
            float lk[16], lbt[16]; bool ok[16];
#pragma unroll
            for (int r = 0; r < 16; ++r) { const int kk = (r & 3) + 8 * (r >> 2) + 4 * hh; const float z = st[r];
                const float L = __builtin_amdgcn_logf(1.0f + __builtin_amdgcn_exp2f(-fabsf(z)));
                ok[r] = diag ? (kk < c) : (meta ? (kk < NMETA) : true);
                lk[r] = ok[r] ? -(fmaxf(z, 0.f) + L) : 0.f; lbt[r] = fminf(z, 0.f) - L; }
            float sg[4], pp[4], tot[4];
#pragma unroll
            for (int g = 0; g < 4; ++g) { sg[g] = (lk[4 * g] + lk[4 * g + 1]) + (lk[4 * g + 2] + lk[4 * g + 3]); pp[g] = __shfl_xor(sg[g], 32); tot[g] = sg[g] + pp[g]; }
            float lat[4]; lat[3] = 0.f; lat[2] = tot[3]; lat[1] = tot[3] + tot[2]; lat[0] = lat[1] + tot[1];
            float w[16];
#pragma unroll
            for (int g = 0; g < 4; ++g) { const float base = R + lat[g] + (hh == 0 ? pp[g] : 0.f);
                const float t3 = base, t2 = t3 + lk[4 * g + 3], t1 = t2 + lk[4 * g + 2], t0 = t1 + lk[4 * g + 1];
                w[4 * g + 3] = ok[4 * g + 3] ? __builtin_amdgcn_exp2f(lbt[4 * g + 3] + t3) : 0.f; w[4 * g + 2] = ok[4 * g + 2] ? __builtin_amdgcn_exp2f(lbt[4 * g + 2] + t2) : 0.f;
                w[4 * g + 1] = ok[4 * g + 1] ? __builtin_amdgcn_exp2f(lbt[4 * g + 1] + t1) : 0.f; w[4 * g + 0] = ok[4 * g + 0] ? __builtin_amdgcn_exp2f(lbt[4 * g + 0] + t0) : 0.f; }
            R += lat[0] + tot[0];
#pragma unroll
            for (int sx = 0; sx < 2; ++sx) {
                v4u wu; wu.x = pg8::cvt_pk_bf16(w[8 * sx + 0], w[8 * sx + 1]); wu.y = pg8::cvt_pk_bf16(w[8 * sx + 2], w[8 * sx + 3]); wu.z = pg8::cvt_pk_bf16(w[8 * sx + 4], w[8 * sx + 5]); wu.w = pg8::cvt_pk_bf16(w[8 * sx + 6], w[8 * sx + 7]);
                const bf16x8 wf = __builtin_bit_cast(bf16x8, wu);
                o0 = __builtin_amdgcn_mfma_f32_32x32x16_bf16(vfr[0][sx], wf, o0, 0, 0, 0);
                o1 = __builtin_amdgcn_mfma_f32_32x32x16_bf16(vfr[1][sx], wf, o1, 0, 0, 0);
            }
            if (__all(R < -160.f)) break;
        }
        float ss = 0.f;
#pragma unroll
        for (int i = 0; i < 16; ++i) ss += o0[i] * o0[i] + o1[i] * o1[i];
        ss += __shfl_xor(ss, 32);
        const float rs = 1.0f / sqrtf(ss * (1.f / 64.f) + EPS);
        bf16* op = MIX + (tok0 + 32 * qb + c) * D + h * 64 + 4 * hh;
#pragma unroll
        for (int g = 0; g < 4; ++g) {
            const f32x4 g0 = *(const f32x4*)(F.sb_gain + h * 64 + 8 * g + 4 * hh), g1 = *(const f32x4*)(F.sb_gain + h * 64 + 32 + 8 * g + 4 * hh);
            v2u w0, w1; w0.x = pg8::cvt_pk_bf16(o0[4 * g] * rs * g0.x, o0[4 * g + 1] * rs * g0.y); w0.y = pg8::cvt_pk_bf16(o0[4 * g + 2] * rs * g0.z, o0[4 * g + 3] * rs * g0.w);
            w1.x = pg8::cvt_pk_bf16(o1[4 * g] * rs * g1.x, o1[4 * g + 1] * rs * g1.y); w1.y = pg8::cvt_pk_bf16(o1[4 * g + 2] * rs * g1.z, o1[4 * g + 3] * rs * g1.w);
            *(v2u*)(op + 8 * g) = w0; *(v2u*)(op + 32 + 8 * g) = w1;
        }
    }
}
template <int B0> __device__ __forceinline__ bf16x8 cvt8(const f32x16& x) {
    v4u a; a.x = pg8::cvt_pk_bf16(x[B0 + 0], x[B0 + 1]); a.y = pg8::cvt_pk_bf16(x[B0 + 2], x[B0 + 3]); a.z = pg8::cvt_pk_bf16(x[B0 + 4], x[B0 + 5]); a.w = pg8::cvt_pk_bf16(x[B0 + 6], x[B0 + 7]); return __builtin_bit_cast(bf16x8, a); }
__device__ __forceinline__ bf16x8 mk8(const bf16* p) { const v2u lo = *(const v2u*)p, hi = *(const v2u*)(p + 8); v4u a; a.x = lo.x; a.y = lo.y; a.z = hi.x; a.w = hi.y; return __builtin_bit_cast(bf16x8, a); }
__device__ __forceinline__ void hgrn_update(f32x16 (&S)[4], const bf16x8 (&kh)[8], const LAS float* egl, const bf16x8 (&idf)[2], const bf16x8 (&vf)[2]) {
#pragma unroll
    for (int i = 0; i < 4; ++i) {
#pragma unroll
        for (int g = 0; g < 4; ++g) { const f32x4 d = *(const LAS f32x4*)(egl + 32 * i + 8 * g); S[i][4 * g] *= d.x; S[i][4 * g + 1] *= d.y; S[i][4 * g + 2] *= d.z; S[i][4 * g + 3] *= d.w; }
        f32x16 X;
#pragma unroll
        for (int r = 0; r < 16; ++r) X[r] = 0.f;
        X = __builtin_amdgcn_mfma_f32_32x32x16_bf16(kh[2 * i], idf[0], X, 0, 0, 0); X = __builtin_amdgcn_mfma_f32_32x32x16_bf16(kh[2 * i + 1], idf[1], X, 0, 0, 0);
        S[i] = __builtin_amdgcn_mfma_f32_32x32x16_bf16(cvt8<0>(X), vf[0], S[i], 0, 0, 0); S[i] = __builtin_amdgcn_mfma_f32_32x32x16_bf16(cvt8<8>(X), vf[1], S[i], 0, 0, 0);
    }
}
template <bool OUT> __device__ __forceinline__ void p2_hgrn(Frame& F) {
    const bf16* QT = (const bf16*)(F.ws + WS_QT); const bf16* KT = (const bf16*)(F.ws + WS_KT); const bf16* KH = (const bf16*)(F.ws + WS_KH); const bf16* VT = (const bf16*)(F.ws + WS_VT);
    const bf16* HGS = (const bf16*)(F.ws + WS_HGS); const float* EGL = (const float*)(F.ws + WS_EGL); float* SST = (float*)(F.ws + WS_SST); bf16* MIX = (bf16*)(F.ws + WS_MIXED);
    const int c = F.lane & 31, hh = F.lane >> 5, slot = F.wave >> 2, dvb = F.wave & 3, tu = (F.wave & 3) * 64 + F.lane;
    LAS float* red = (LAS float*)(F.lds);
    LAS float* eglL = (LAS float*)(F.lds + 2048) + slot * 1024;
    LAS float* gnL = (LAS float*)(F.lds + 2048 + 8192) + slot * 128;
    bf16x8 idf[2];
#pragma unroll
    for (int st = 0; st < 2; ++st) { v4u a; a.x = a.y = a.z = a.w = 0u; const int j = c - 16 * st - 8 * hh;
        if (j >= 0 && j < 8) { const unsigned one = (j & 1) ? 0x3F800000u : 0x00003F80u; if ((j >> 1) == 0) a.x = one; else if ((j >> 1) == 1) a.y = one; else if ((j >> 1) == 2) a.z = one; else a.w = one; }
        idf[st] = __builtin_bit_cast(bf16x8, a); }
    for (int ub = F.bx * 2; ub < NB * HGH * 16; ub += F.G * 2) {
        const int u = ub + slot, b = u >> 6, h = (u >> 4) & 3, jc = u & 15;
        const size_t tok0 = (size_t)b * SEQ + 256 * jc; const int ch0 = (int)(tok0 >> 5);
        float* sst = SST + ((size_t)(u * 4 + dvb) * 16) * 256 + F.lane * 4;
        __syncthreads();
        *(LAS f32x4*)(eglL + tu * 4) = *(const f32x4*)(EGL + (size_t)(ch0 + (tu >> 5)) * 512 + h * 128 + (tu & 31) * 4);
        if (OUT && tu < 32) *(LAS f32x4*)(gnL + tu * 4) = *(const f32x4*)(F.hg_gain + h * 128 + tu * 4);
        f32x16 S[4];
        if (OUT) {
#pragma unroll
            for (int i = 0; i < 4; ++i)
#pragma unroll
                for (int g = 0; g < 4; ++g) { const f32x4 v = *(const f32x4*)(sst + (i * 4 + g) * 256); S[i][4 * g] = v.x; S[i][4 * g + 1] = v.y; S[i][4 * g + 2] = v.z; S[i][4 * g + 3] = v.w; }
        } else {
#pragma unroll
            for (int i = 0; i < 4; ++i)
#pragma unroll
                for (int r = 0; r < 16; ++r) S[i][r] = 0.f;
        }
        __syncthreads();
        for (int cs = 0; cs < 8; ++cs) {
            const size_t tokc = tok0 + 32 * cs;
            const bf16* vp = VT + vtf_off(16 + 4 * h + dvb, NTOK / 32, ch0 + cs, 0, hh, c);
            bf16x8 vf[2]; vf[0] = *(const bf16x8*)vp; vf[1] = *(const bf16x8*)(vp + 512);
            const bf16* khp = KH + frag_off(ch0 + cs, h * 8, hh, c);
            bf16x8 kh[8];
            if (OUT) {
                const bf16* qp = QT + frag_off(ch0 + cs, h * 8, hh, c); const bf16* kp = KT + frag_off(ch0 + cs, h * 8, hh, c);
                const int dcol = h * 128 + 32 * dvb + 4 * hh;
                bf16x8 qf[8], kt[8]; v2u gs[4];
#pragma unroll
                for (int ks = 0; ks < 8; ++ks) { kt[ks] = *(const bf16x8*)(kp + ks * 512); qf[ks] = *(const bf16x8*)(qp + ks * 512); }
#pragma unroll
                for (int g = 0; g < 4; ++g) gs[g] = *(const v2u*)(HGS + (tokc + c) * 512 + dcol + 8 * g);
                f32x16 P;
#pragma unroll
                for (int r = 0; r < 16; ++r) P[r] = 0.f;
#pragma unroll
                for (int ks = 0; ks < 8; ++ks) P = __builtin_amdgcn_mfma_f32_32x32x16_bf16(kt[ks], qf[ks], P, 0, 0, 0);
#pragma unroll
                for (int ks = 0; ks < 8; ++ks) kh[ks] = *(const bf16x8*)(khp + ks * 512);
#pragma unroll
                for (int r = 0; r < 16; ++r) { const int srow = (r & 3) + 8 * (r >> 2) + 4 * hh; P[r] = (srow <= c) ? P[r] : 0.f; }
                f32x16 O;
#pragma unroll
                for (int r = 0; r < 16; ++r) O[r] = 0.f;
                O = __builtin_amdgcn_mfma_f32_32x32x16_bf16(vf[0], cvt8<0>(P), O, 0, 0, 0); O = __builtin_amdgcn_mfma_f32_32x32x16_bf16(vf[1], cvt8<8>(P), O, 0, 0, 0);
#pragma unroll
                for (int i = 0; i < 4; ++i) { O = __builtin_amdgcn_mfma_f32_32x32x16_bf16(cvt8<0>(S[i]), qf[2 * i], O, 0, 0, 0); O = __builtin_amdgcn_mfma_f32_32x32x16_bf16(cvt8<8>(S[i]), qf[2 * i + 1], O, 0, 0, 0); }
                float ss = 0.f;
#pragma unroll
                for (int r = 0; r < 16; ++r) ss += O[r] * O[r];
                ss += __shfl_xor(ss, 32);
                LAS float* rp = red + ((slot * 2 + (cs & 1)) * 4) * 32;
                if (hh == 0) rp[dvb * 32 + c] = ss;
                __syncthreads();
                const float tot = (rp[c] + rp[32 + c]) + (rp[64 + c] + rp[96 + c]);
                const float rs = 1.0f / sqrtf(tot * (1.f / 128.f) + EPS);
                bf16* op = MIX + (tokc + c) * D + 512 + dcol; v2u w[4];
#pragma unroll
                for (int g = 0; g < 4; ++g) { const f32x4 gn = *(const LAS f32x4*)(gnL + 32 * dvb + 4 * hh + 8 * g);
                    w[g].x = pg8::cvt_pk_bf16(O[4 * g] * rs * gn.x * bflo(gs[g].x), O[4 * g + 1] * rs * gn.y * bfhi(gs[g].x)); w[g].y = pg8::cvt_pk_bf16(O[4 * g + 2] * rs * gn.z * bflo(gs[g].y), O[4 * g + 3] * rs * gn.w * bfhi(gs[g].y)); }
#pragma unroll
                for (int g = 0; g < 4; ++g) *(v2u*)(op + 8 * g) = w[g];
            } else {
#pragma unroll
                for (int ks = 0; ks < 8; ++ks) kh[ks] = *(const bf16x8*)(khp + ks * 512);
            }
            hgrn_update(S, kh, eglL + cs * 128 + 4 * hh, idf, vf);
        }
        if (!OUT) {
#pragma unroll
            for (int i = 0; i < 4; ++i)
#pragma unroll
                for (int g = 0; g < 4; ++g) *(f32x4*)(sst + (i * 4 + g) * 256) = (f32x4){S[i][4 * g], S[i][4 * g + 1], S[i][4 * g + 2], S[i][4 * g + 3]};
        }
    }
}
__device__ __forceinline__ void p2_hgrn_scan(Frame& F) {
    float* SST = (float*)(F.ws + WS_SST); const float* EGL = (const float*)(F.ws + WS_EGL); const float* MKH = (const float*)(F.ws + WS_META + META_MKH); const float* MP = (const float*)(F.ws + WS_META);
    for (int id = F.bx * 512 + F.tid; id < NB * HGH * 4096; id += F.G * 512) {
        const int bh = id >> 12, e4 = id & 4095, b = bh >> 2, h = bh & 3;
        const int ln = e4 & 63, g = (e4 >> 6) & 3, i = (e4 >> 8) & 3, dvb = e4 >> 10;
        const int dk = h * 128 + 32 * i + 8 * g + 4 * (ln >> 5), dv = h * 128 + 32 * dvb + (ln & 31);
        f32x4 s = (f32x4){0.f, 0.f, 0.f, 0.f};
        for (int r = 0; r < NMETA; ++r) { const f32x4 kk = *(const f32x4*)(MKH + r * 512 + dk); const float v = MP[(size_t)r * NPROJ + 2560 + dv]; s += kk * v; }
        for (int j = 0; j < 16; ++j) {
            float* p = SST + ((size_t)(bh * 16 + j) * 16384) + e4 * 4;
            const f32x4 loc = *(const f32x4*)p; *(f32x4*)p = s;
            f32x4 dt = (f32x4){1.f, 1.f, 1.f, 1.f};
#pragma unroll
            for (int cs = 0; cs < 8; ++cs) dt *= *(const f32x4*)(EGL + (size_t)(b * 128 + 8 * j + cs) * 512 + dk);
            s = dt * s + loc;
        }
    }
}
__device__ __forceinline__ void p4_router(Frame& F) {
    const bf16* HB = (const bf16*)(F.ws + WS_HB16); const bf16* WRT = (const bf16*)(F.ws + WS_WRT);
    unsigned* LT = (unsigned*)(F.ws + WS_LTOK); float* LGt = (float*)(F.ws + WS_LGATE); float* LRs = (float*)(F.ws + WS_LRSTD);
    LAS float* lg = (LAS float*)(F.lds) + F.wave * (16 * 48 + 16);
    volatile LAS int* M = (volatile LAS int*)F.MISC;
    const int fr = F.lane & 15, fq = F.lane >> 4;
    for (int tile = F.bx; tile < NTOK / 128; tile += F.G) {
        if (F.tid < NE) M[80 + F.tid] = 0;
        __syncthreads();
        const int row0 = tile * 128 + F.wave * 16;
        pg8::f32x4 acc[3]; acc[0] = acc[1] = acc[2] = (pg8::f32x4){0.f, 0.f, 0.f, 0.f}; float ss = 0.f;
        const bf16* ap = HB + (size_t)(row0 + fr) * D + 8 * fq; const bf16* bp = WRT + (size_t)fr * D + 8 * fq;
#pragma unroll 4
        for (int ks = 0; ks < 32; ++ks) {
            const bf16x8 a = *(const bf16x8*)(ap + 32 * ks);
            const v4u au = __builtin_bit_cast(v4u, a);
            ss += bflo(au.x) * bflo(au.x) + bfhi(au.x) * bfhi(au.x) + bflo(au.y) * bflo(au.y) + bfhi(au.y) * bfhi(au.y) + bflo(au.z) * bflo(au.z) + bfhi(au.z) * bfhi(au.z) + bflo(au.w) * bflo(au.w) + bfhi(au.w) * bfhi(au.w);
#pragma unroll
            for (int nt = 0; nt < 3; ++nt) { const bf16x8 bb = *(const bf16x8*)(bp + (size_t)nt * 16 * D + 32 * ks); acc[nt] = __builtin_amdgcn_mfma_f32_16x16x32_bf16(a, bb, acc[nt], 0, 0, 0); }
        }
        ss += __shfl_xor(ss, 16); ss += __shfl_xor(ss, 32);
#pragma unroll
        for (int nt = 0; nt < 3; ++nt)
#pragma unroll
            for (int j = 0; j < 4; ++j) lg[(fq * 4 + j) * 48 + nt * 16 + fr] = acc[nt][j];
        if (fq == 0) lg[16 * 48 + fr] = ss;
        __syncthreads();
        int e1 = 0, e2 = 0, r1 = 0, r2 = 0; float g1 = 0.f, g2 = 0.f, rstd = 0.f;
        if (F.lane < 16) {
            rstd = 1.0f / sqrtf(lg[16 * 48 + F.lane] * (1.f / D) + EPS);
            const LAS float* l = lg + F.lane * 48;
            float gl[4]; int gi = 0;
#pragma unroll
            for (int i = 0; i < 4; ++i) gl[i] = l[i] * rstd + F.b_rg[i];
#pragma unroll
            for (int i = 1; i < 4; ++i) if (gl[i] > gl[gi]) gi = i;
            float den = 0.f;
#pragma unroll
            for (int i = 0; i < 4; ++i) den += __expf(gl[i] - gl[gi]);
            const float pg = 1.0f / den;
            float v1 = -3.0e38f, v2 = -3.0e38f; int i1 = 0, i2 = 0;
            for (int i = 0; i < 8; ++i) { const float v = l[4 + gi * 8 + i] * rstd + F.b_re[gi * 8 + i]; if (v > v1) { v2 = v1; i2 = i1; v1 = v; i1 = i; } else if (v > v2) { v2 = v; i2 = i; } }
            const float ex = __expf(v2 - v1); g1 = pg / (1.f + ex); g2 = pg * ex / (1.f + ex);
            e1 = gi * 8 + i1; e2 = gi * 8 + i2;
            r1 = __hip_atomic_fetch_add((LAS int*)&M[80 + e1], 1, __ATOMIC_RELAXED, __HIP_MEMORY_SCOPE_WORKGROUP); r2 = __hip_atomic_fetch_add((LAS int*)&M[80 + e2], 1, __ATOMIC_RELAXED, __HIP_MEMORY_SCOPE_WORKGROUP);
        }
        __syncthreads();
        if (F.tid < NE) { const int n = M[80 + F.tid]; M[120 + F.tid] = n ? (int)__hip_atomic_fetch_add(F.ctl + CW_CNT + 64 * F.tid, (unsigned)n, RLX_AGENT) : 0; }
        __syncthreads();
        if (F.lane < 16) { const unsigned tok = (unsigned)(row0 + F.lane);
            const size_t p1 = (size_t)e1 * LCAP + M[120 + e1] + r1, p2 = (size_t)e2 * LCAP + M[120 + e2] + r2;
            LT[p1] = tok; LGt[p1] = g1; LRs[p1] = rstd; LT[p2] = tok | 0x40000000u; LGt[p2] = g2; LRs[p2] = rstd; }
        __syncthreads();
    }
}
__device__ __forceinline__ void p7_final(Frame& F) {
    const bf16* H = (const bf16*)(F.ws + WS_HB16); const bf16* Y0 = (const bf16*)(F.ws + WS_Y0); const bf16* Y1 = (const bf16*)(F.ws + WS_Y1);
    const int gw = F.bx * NWAVES + F.wave, NGW = F.G * NWAVES;
    f32x4 gf[4];
#pragma unroll
    for (int j = 0; j < 4; ++j) gf[j] = *(const f32x4*)(F.g_final + 4 * F.lane + 256 * j);
    for (int m0 = gw * 2; m0 < NTOK; m0 += NGW * 2) {
        v2u hv[2][4], a[2][4], b[2][4];
#pragma unroll
        for (int r = 0; r < 2; ++r) { const GAS v2u* hr = (const GAS v2u*)(H + (size_t)(m0 + r) * D) + F.lane; const GAS v2u* y0 = (const GAS v2u*)(Y0 + (size_t)(m0 + r) * D) + F.lane; const GAS v2u* y1 = (const GAS v2u*)(Y1 + (size_t)(m0 + r) * D) + F.lane;
#pragma unroll
            for (int j = 0; j < 4; ++j) { hv[r][j] = __builtin_nontemporal_load(hr + 64 * j); a[r][j] = __builtin_nontemporal_load(y0 + 64 * j); b[r][j] = __builtin_nontemporal_load(y1 + 64 * j); } }
#pragma unroll
        for (int r = 0; r < 2; ++r) { f32x4 v[4]; float s = 0.f;
#pragma unroll
            for (int j = 0; j < 4; ++j) { v[j].x = bflo(hv[r][j].x) + bflo(a[r][j].x) + bflo(b[r][j].x); v[j].y = bfhi(hv[r][j].x) + bfhi(a[r][j].x) + bfhi(b[r][j].x); v[j].z = bflo(hv[r][j].y) + bflo(a[r][j].y) + bflo(b[r][j].y); v[j].w = bfhi(hv[r][j].y) + bfhi(a[r][j].y) + bfhi(b[r][j].y);
                s += (v[j].x * v[j].x + v[j].y * v[j].y) + (v[j].z * v[j].z + v[j].w * v[j].w); }
            const float rstd = 1.0f / sqrtf(wave_sum(s) * (1.f / D) + EPS);
            GAS f32x4* o = (GAS f32x4*)(F.out + (size_t)(m0 + r) * D) + F.lane;
#pragma unroll
            for (int j = 0; j < 4; ++j) __builtin_nontemporal_store(v[j] * rstd * gf[j], o + 64 * j); }
    }
}

constexpr int NPHASES = 10;
__global__ void __launch_bounds__(NWAVES * 64, 2) hymba_fwd(Args args) {
    extern __shared__ __attribute__((aligned(16))) unsigned char lds[];
    Frame F;
    F.lds = (LAS unsigned char*)lds; F.MISC = (volatile LAS unsigned*)(F.lds + MISC_OFF);
    F.tid = threadIdx.x; F.lane = F.tid & 63; F.wave = __builtin_amdgcn_readfirstlane(F.tid >> 6); F.G = gridDim.x; F.bx = blockIdx.x;
    F.ws = args.ws; F.ctl = (gu32*)(args.ws + WS_CTL); F.out = args.out;
    F.x = args.in[0]; F.meta = args.in[1]; F.lb_logits = args.in[2]; F.g_mix = args.in[3]; F.w_in = args.in[4]; F.sb_gain = args.in[5]; F.hg_gain = args.in[6]; F.w_out = args.in[7]; F.g_ffn = args.in[8];
    F.w_rg = args.in[9]; F.b_rg = args.in[10]; F.w_re = args.in[11]; F.b_re = args.in[12]; F.w_gate = args.in[13]; F.w_up = args.in[14]; F.w_down = args.in[15]; F.g_final = args.in[16];
    for (int u = F.tid; u < 256; u += NWAVES * 64) F.MISC[u] = 0u;
    __syncthreads();
#if !MK_PER_PHASE
    XcdBarrier bar = xcd_barrier_post((unsigned*)(F.ctl + CW_BAR), F.MISC + 200);
#define GRID_BAR() xcd_barrier(bar)
#else
#define GRID_BAR() do {} while (0)
#endif
    const int lo = args.ph_lo, hi = args.ph_hi;
#define IN(k) (lo <= (k) && (k) < hi)
#define BOTH(k) (IN(k) && IN((k) + 1))
    unsigned char* ws = args.ws;

#ifndef SKIP_P0
    if (IN(0)) { p0_prologue(F); if (BOTH(0)) GRID_BAR(); }
#endif

#ifndef SKIP_P1
    if (IN(1)) {
        { pg8::StaticOrder S; S.init(ws + WS_XB, ws + WS_WIN, NTOK, 2560, D, F.G, F.bx);
          EpiInProj E{(const float*)(ws + WS_RSTD1), (const float*)(ws + WS_META + META_LB), (bf16*)(ws + WS_SQ), (bf16*)(ws + WS_SK), (bf16*)(ws + WS_QT), (bf16*)(ws + WS_KT), (bf16*)(ws + WS_KH), (float*)(ws + WS_EGL), (bf16*)(ws + WS_HGS)};
          pg8::gemm_phase<EpiInProj, pg8::StaticOrder>(F.lds + RING_OFF, D, S, E); }
        { pg8::StaticOrder S; S.init(ws + WS_WIN + (size_t)2560 * D * 2, ws + WS_XB, 1024, NTOK, D, F.G, F.bx);
          EpiVT E{(const float*)(ws + WS_RSTD1), (bf16*)(ws + WS_VT)};
          pg8::gemm_phase<EpiVT, pg8::StaticOrder>(F.lds + RING_OFF, D, S, E); }
        if (BOTH(1)) GRID_BAR();
    }
#endif
#ifndef SKIP_P2
    if (IN(2)) { p2_hgrn<false>(F); if (PROBE_DUP == 2) p2_hgrn<false>(F); p2_attention(F); if (PROBE_DUP == 1) p2_attention(F); if (BOTH(2)) GRID_BAR(); }
    if (IN(3)) { p2_hgrn_scan(F); if (BOTH(3)) GRID_BAR(); }
    if (IN(4)) { p2_hgrn<true>(F); if (PROBE_DUP == 3) p2_hgrn<true>(F); if (BOTH(4)) GRID_BAR(); }
#endif
#ifndef SKIP_P3
    if (IN(5)) {
        pg8::StaticOrder S; S.init(ws + WS_MIXED, ws + WS_WOUT, NTOK, D, D, F.G, F.bx);
        EpiOutProj E{F.x, (bf16*)(ws + WS_HB16)};
        pg8::gemm_phase<EpiOutProj, pg8::StaticOrder>(F.lds + RING_OFF, D, S, E);
        if (BOTH(5)) GRID_BAR();
    }
#endif
#ifndef SKIP_P4
    if (IN(6)) { p4_router(F); if (BOTH(6)) GRID_BAR(); }
#endif

#ifndef SKIP_P5
    if (IN(7)) {
        const int nunits = moe_setup(F, 0);
        MoeOrder<true> S{(const LAS int*)F.MISC, (const LAS int*)F.MISC + 40, (const LAS unsigned*)(F.lds + LIST_OFF), (const char*)(ws + WS_HB16), (const char*)(ws + WS_WGU), D, F.G, F.bx, nunits};
        EpiGateUp E{(const LAS float*)(F.lds + LIST_OFF + 8192), (bf16*)(ws + WS_HBUF)};
        pg8::gemm_phase<EpiGateUp, MoeOrder<true>>(F.lds + RING_OFF, D, S, E);
        if (BOTH(7)) GRID_BAR();
    }
#endif
#ifndef SKIP_P6
    if (IN(8)) {
        const int nunits = moe_setup(F, 1);
        MoeOrder<false> S{(const LAS int*)F.MISC, (const LAS int*)F.MISC + 40, (const LAS unsigned*)(F.lds + LIST_OFF), (const char*)(ws + WS_HBUF), (const char*)(ws + WS_WDN), FF, F.G, F.bx, nunits};
        EpiDown E{(const LAS unsigned*)(F.lds + LIST_OFF), (const LAS float*)(F.lds + LIST_OFF + 8192), (bf16*)(ws + WS_Y0), (bf16*)(ws + WS_Y1)};
        pg8::gemm_phase<EpiDown, MoeOrder<false>>(F.lds + RING_OFF, FF, S, E);
        if (BOTH(8)) GRID_BAR();
    }
#endif
#ifndef SKIP_P7
    if (IN(9)) p7_final(F);
#endif
#undef IN
#undef BOTH
}

extern "C" void kernel_launch(void* const* d_in, const int* in_sizes, int n_in, void* d_out, int out_size, void* d_ws, size_t ws_size, hipStream_t stream) {
    static int grid = 0;
    if (grid == 0) {
        if (n_in != 17 || in_sizes[0] != NTOK * D || out_size != NTOK * D || ws_size < WS_END) { fprintf(stderr, "kernel_launch: unexpected shapes (n_in %d, in0 %d, out %d, ws %zu)\n", n_in, n_in > 0 ? in_sizes[0] : -1, out_size, ws_size); grid = -1; return; }
        int dev = 0, cus = 0, per_cu = 0;
        if (hipGetDevice(&dev) != hipSuccess || hipDeviceGetAttribute(&cus, hipDeviceAttributeMultiprocessorCount, dev) != hipSuccess) { grid = -1; return; }
        if (hipFuncSetAttribute((const void*)hymba_fwd, hipFuncAttributeMaxDynamicSharedMemorySize, LDS_BYTES) != hipSuccess) { fprintf(stderr, "kernel_launch: hipFuncSetAttribute failed\n"); grid = -1; return; }
        if (hipOccupancyMaxActiveBlocksPerMultiprocessor(&per_cu, (const void*)hymba_fwd, NWAVES * 64, LDS_BYTES) != hipSuccess || per_cu < 1) { fprintf(stderr, "kernel_launch: occupancy query says %d\n", per_cu); }
        (void)hipGetLastError();
        grid = cus;
    }
    if (grid < 0) return;
    hipMemsetAsync((char*)d_ws + WS_CTL, 0, CTL_ZERO_BYTES, stream);
    Args a{};
    for (int i = 0; i < 17; ++i) a.in[i] = (const float*)d_in[i];
    a.out = (float*)d_out; a.ws = (unsigned char*)d_ws;
#if MK_PER_PHASE
    for (int p = 0; p < NPHASES; ++p) { a.ph_lo = p; a.ph_hi = p + 1; hipLaunchKernelGGL(hymba_fwd, dim3(grid), dim3(NWAVES * 64), LDS_BYTES, stream, a); }
#else
    a.ph_lo = 0; a.ph_hi = NPHASES; hipLaunchKernelGGL(hymba_fwd, dim3(grid), dim3(NWAVES * 64), LDS_BYTES, stream, a);
    if (PROBE_RELAUNCH >= 0) { a.ph_lo = PROBE_RELAUNCH; a.ph_hi = PROBE_RELAUNCH + 1; hipLaunchKernelGGL(hymba_fwd, dim3(grid), dim3(NWAVES * 64), LDS_BYTES, stream, a); }
#endif
}
```
